# Optimizing an MI355X kernel written in HIP

```python
import jax, jax.numpy as jnp
from jax import lax
import numpy as np

D_MODEL = 2048
BATCH = 4
SEQ = 4096
DEPTH = 1

EPS = 1e-6
A_HEADS = 16
A_KV_HEADS = 4
A_HEAD_DIM = 64
A_WIDTH = A_HEADS * A_HEAD_DIM
A_KV_WIDTH = A_KV_HEADS * A_HEAD_DIM
WINDOW = 128
BLOCK = 128
ROT_DIM = A_HEAD_DIM // 4
ROPE_THETA = 500000.0
B_HEADS = 8
B_KEY_DIM = 128
B_VAL_DIM = 128
B_KEY_WIDTH = B_HEADS * B_KEY_DIM
B_WIDTH = B_HEADS * B_VAL_DIM
CHUNK = 64
FF_DIM = 5632
PLE_DIM = 256
SPLITS = (A_WIDTH, A_KV_WIDTH, A_KV_WIDTH, B_KEY_WIDTH, B_KEY_WIDTH, B_WIDTH, B_WIDTH, D_MODEL, D_MODEL)
IN_DIM = A_WIDTH + 2 * A_KV_WIDTH + 2 * B_KEY_WIDTH + 2 * B_WIDTH + 2 * D_MODEL

kernel_name = "hybrid_swa_sink_hgrn2_macaron_ple"


def rmsnorm(x, w):
    x32 = x.astype(jnp.float32)
    y = x32 * lax.rsqrt(jnp.mean(x32 * x32, axis=-1, keepdims=True) + EPS)
    return (y * w.astype(jnp.float32)).astype(x.dtype)


def swiglu(h, w_gate, w_up, w_down):
    return (jax.nn.silu(h @ w_gate) * (h @ w_up)) @ w_down


def partial_rope(t, positions):
    t32 = t.astype(jnp.float32)
    rot, rest = t32[..., :ROT_DIM], t32[..., ROT_DIM:]
    inv_freq = jnp.power(jnp.float32(ROPE_THETA), -jnp.arange(0, ROT_DIM, 2, dtype=jnp.float32) / ROT_DIM)
    ang = positions.astype(jnp.float32)[..., None] * inv_freq
    cos, sin = jnp.cos(ang)[:, :, None, :], jnp.sin(ang)[:, :, None, :]
    x1, x2 = rot[..., :ROT_DIM // 2], rot[..., ROT_DIM // 2:]
    out = jnp.concatenate([x1 * cos - x2 * sin, x2 * cos + x1 * sin, rest], axis=-1)
    return out.astype(t.dtype)


def sliding_window_attention(q, k, v, sinks):
    b, s = q.shape[0], q.shape[1]
    nb = s // BLOCK
    g = A_HEADS // A_KV_HEADS
    qb = q.reshape(b, nb, BLOCK, A_KV_HEADS, g, A_HEAD_DIM)
    kb = k.reshape(b, nb, BLOCK, A_KV_HEADS, A_HEAD_DIM)
    vb = v.reshape(b, nb, BLOCK, A_KV_HEADS, A_HEAD_DIM)

    def with_prev(t):
        prev = jnp.pad(t[:, :-1], ((0, 0), (1, 0), (0, 0), (0, 0), (0, 0)))
        return jnp.concatenate([prev, t], axis=2)

    kk, vv = with_prev(kb), with_prev(vb)
    scale = A_HEAD_DIM ** -0.5
    scores = jnp.einsum('bnqhgd,bnkhd->bnhgqk', qb, kk).astype(jnp.float32) * scale
    qi = jnp.arange(BLOCK)[:, None]
    kj = jnp.arange(2 * BLOCK)[None, :]
    dist = qi + BLOCK - kj
    blk = jnp.arange(nb)[:, None, None]
    allowed = (dist >= 0) & (dist < WINDOW) & ((blk > 0) | (kj >= BLOCK))
    scores = jnp.where(allowed[None, :, None, None], scores, -jnp.inf)
    sink = sinks.astype(jnp.float32).reshape(A_KV_HEADS, g)[None, None, :, :, None, None]
    m = jnp.maximum(jnp.max(scores, axis=-1, keepdims=True), sink)
    e = jnp.exp(scores - m)
    denom = jnp.sum(e, axis=-1, keepdims=True) + jnp.exp(sink - m)
    probs = (e / denom).astype(v.dtype)
    o = jnp.einsum('bnhgqk,bnkhd->bnqhgd', probs, vv)
    return o.reshape(b, s, A_WIDTH)


def hgrn2_chunk_step(state, inp):
    q, k, v, log_f = inp
    cum = jnp.cumsum(log_f, axis=2)
    causal = jnp.tril(jnp.ones((CHUNK, CHUNK), dtype=bool))
    diff = cum[:, :, :, None, :] - cum[:, :, None, :, :]
    decay = jnp.exp(jnp.where(causal[None, None, :, :, None], diff, -jnp.inf))
    scores = jnp.einsum('bhtd,bhsd,bhtsd->bhts', q, k, decay)
    o = scores @ v + jnp.einsum('bhtd,bhde->bhte', q * jnp.exp(cum), state)
    last = cum[:, :, -1:, :]
    new_state = jnp.exp(last[:, :, 0, :])[..., None] * state + jnp.einsum('bhsd,bhse->bhde', k * jnp.exp(last - cum), v)
    return new_state, o


def hgrn2(q_pre, f_pre, i_in, lb):
    b, s = q_pre.shape[0], q_pre.shape[1]
    nc = s // CHUNK
    f32 = f_pre.astype(jnp.float32)
    q = jax.nn.silu(q_pre.astype(jnp.float32))
    log_f = jnp.logaddexp(jnp.log(lb), jnp.log1p(-lb) + jax.nn.log_sigmoid(f32))
    k = (1.0 - lb) * jax.nn.sigmoid(-f32)
    v = i_in.astype(jnp.float32)

    def to_chunks(t):
        return t.reshape(b, nc, CHUNK, B_HEADS, t.shape[-1]).transpose(1, 0, 3, 2, 4)

    state0 = jnp.zeros((b, B_HEADS, B_KEY_DIM, B_VAL_DIM), jnp.float32)
    _, o = lax.scan(hgrn2_chunk_step, state0, (to_chunks(q), to_chunks(k), to_chunks(v), to_chunks(log_f)))
    return o.transpose(1, 0, 3, 2, 4).reshape(b, s, B_HEADS, B_VAL_DIM)


def setup_inputs(seed: int = 0) -> dict:
    key = jax.random.key(seed)
    ks = jax.random.split(key, 24)

    def nrm(k, shape, fan_in):
        return jax.random.normal(k, shape, jnp.float32) * fan_in ** -0.5

    def gain(k, shape):
        return 1.0 + 0.02 * jax.random.normal(k, shape, jnp.float32)

    return {
        "x": jax.random.normal(ks[0], (BATCH, SEQ, D_MODEL), jnp.float32),
        "p": jax.random.normal(ks[1], (DEPTH, BATCH, SEQ, PLE_DIM), jnp.float32),
        "positions": jnp.broadcast_to(jnp.arange(SEQ, dtype=jnp.int32), (BATCH, SEQ)),
        "ffn1_norm": gain(ks[2], (DEPTH, D_MODEL)),
        "ffn1_w_gate": nrm(ks[3], (DEPTH, D_MODEL, FF_DIM), D_MODEL),
        "ffn1_w_up": nrm(ks[4], (DEPTH, D_MODEL, FF_DIM), D_MODEL),
        "ffn1_w_down": nrm(ks[5], (DEPTH, FF_DIM, D_MODEL), FF_DIM),
        "mix_norm": gain(ks[6], (DEPTH, D_MODEL)),
        "w_in": nrm(ks[7], (DEPTH, D_MODEL, IN_DIM), D_MODEL),
        "attn_sinks": 0.5 * jax.random.normal(ks[8], (DEPTH, A_HEADS), jnp.float32),
        "hgrn_lower_bound": 0.1 * jax.random.normal(ks[9], (DEPTH + 1, B_KEY_WIDTH), jnp.float32),
        "hgrn_norm": gain(ks[10], (DEPTH, B_WIDTH)),
        "w_up_a": nrm(ks[11], (DEPTH, A_WIDTH, D_MODEL), A_WIDTH),
        "w_up_b": nrm(ks[12], (DEPTH, B_WIDTH, D_MODEL), B_WIDTH),
        "w_out": nrm(ks[13], (DEPTH, D_MODEL, D_MODEL), D_MODEL),
        "ffn2_norm": gain(ks[14], (DEPTH, D_MODEL)),
        "ffn2_w_gate": nrm(ks[15], (DEPTH, D_MODEL, FF_DIM), D_MODEL),
        "ffn2_w_up": nrm(ks[16], (DEPTH, D_MODEL, FF_DIM), D_MODEL),
        "ffn2_w_down": nrm(ks[17], (DEPTH, FF_DIM, D_MODEL), FF_DIM),
        "ple_norm": gain(ks[18], (DEPTH, D_MODEL)),
        "ple_w_gate": nrm(ks[19], (DEPTH, D_MODEL, D_MODEL), D_MODEL),
        "ple_w_proj": nrm(ks[20], (DEPTH, PLE_DIM, D_MODEL), PLE_DIM),
        "final_norm": gain(ks[21], (D_MODEL,)),
    }


def reference(x, p, positions, ffn1_norm, ffn1_w_gate, ffn1_w_up, ffn1_w_down, mix_norm, w_in,
              attn_sinks, hgrn_lower_bound, hgrn_norm, w_up_a, w_up_b, w_out, ffn2_norm,
              ffn2_w_gate, ffn2_w_up, ffn2_w_down, ple_norm, ple_w_gate, ple_w_proj, final_norm):
    b, s = x.shape[0], x.shape[1]
    offsets = np.cumsum(SPLITS)[:-1].tolist()
    lb_all = jnp.cumsum(jax.nn.softmax(hgrn_lower_bound.astype(jnp.float32), axis=0), axis=0)
    for l in range(DEPTH):
        h = rmsnorm(x, ffn1_norm[l])
        x = x + 0.5 * swiglu(h, ffn1_w_gate[l], ffn1_w_up[l], ffn1_w_down[l])

        h = rmsnorm(x, mix_norm[l])
        proj = h @ w_in[l]
        q_a, k_a, v_a, q_b, f_b, i_b, og_b, gate_a, gate_b = jnp.split(proj, offsets, axis=-1)

        q_a = partial_rope(q_a.reshape(b, s, A_HEADS, A_HEAD_DIM), positions)
        k_a = partial_rope(k_a.reshape(b, s, A_KV_HEADS, A_HEAD_DIM), positions)
        v_a = v_a.reshape(b, s, A_KV_HEADS, A_HEAD_DIM)
        out_a = sliding_window_attention(q_a, k_a, v_a, attn_sinks[l])

        lb = lb_all[l].reshape(B_HEADS, B_KEY_DIM)
        o_b = hgrn2(q_b.reshape(b, s, B_HEADS, B_KEY_DIM), f_b.reshape(b, s, B_HEADS, B_KEY_DIM),
                    i_b.reshape(b, s, B_HEADS, B_VAL_DIM), lb)
        o_b = rmsnorm(o_b, hgrn_norm[l].reshape(B_HEADS, B_VAL_DIM)).astype(x.dtype)
        out_b = (o_b * jax.nn.silu(og_b.reshape(b, s, B_HEADS, B_VAL_DIM))).reshape(b, s, B_WIDTH)

        merged = jax.nn.sigmoid(gate_a) * (out_a @ w_up_a[l]) + jax.nn.sigmoid(gate_b) * (out_b @ w_up_b[l])
        x = x + merged @ w_out[l]

        h = rmsnorm(x, ffn2_norm[l])
        x = x + 0.5 * swiglu(h, ffn2_w_gate[l], ffn2_w_up[l], ffn2_w_down[l])

        g = jax.nn.sigmoid(rmsnorm(x, ple_norm[l]) @ ple_w_gate[l])
        x = x + g * (p[l].astype(x.dtype) @ ple_w_proj[l])
    return rmsnorm(x, final_norm)
```

```cpp
#include <hip/hip_runtime.h>
#include <hip/hip_cooperative_groups.h>
#include <cstdio>
#include <cstdint>
namespace cg = cooperative_groups;

#define LAS __attribute__((address_space(3)))
typedef unsigned short bf16_t;
typedef short bf16x8 __attribute__((ext_vector_type(8)));
typedef float f32x4 __attribute__((ext_vector_type(4)));
typedef unsigned u32x4 __attribute__((ext_vector_type(4)));
typedef unsigned u32x2 __attribute__((ext_vector_type(2)));

constexpr int NBATCH = 4, SEQ = 4096, T = NBATCH * SEQ, DM = 2048, FF = 5632, IND = 9728, PLE = 256;
constexpr float EPS = 1e-6f;
constexpr float LOG2E = 1.4426950408889634f;
constexpr float QSCALE = 0.125f * LOG2E;
constexpr int NWAVES = 8, NTHREADS = NWAVES * 64;
constexpr int LDS_BYTES = 147456;

constexpr size_t MiB = 1u << 20;
constexpr size_t WS_ROPE = 0;
constexpr size_t WS_WA_GU = 1 * MiB, WS_WA_D = 45 * MiB;
constexpr size_t WS_STATE = 1 * MiB;
constexpr size_t WS_WIN = 67 * MiB;
constexpr size_t WS_PBF = 67 * MiB, WS_DECAY = 75 * MiB;
constexpr size_t WS_WUA = 105 * MiB, WS_WUB = 109 * MiB, WS_WOUT = 113 * MiB, WS_WPG = 121 * MiB, WS_WPP = 129 * MiB;
constexpr size_t WS_H = 130 * MiB;
constexpr size_t WS_OUTA = 130 * MiB, WS_OUTB = 162 * MiB;
constexpr size_t WS_ACT = 194 * MiB;
constexpr size_t WS_Q = 194 * MiB, WS_K = 226 * MiB, WS_V = 234 * MiB, WS_QB = 242 * MiB, WS_IB = 274 * MiB, WS_OG = 306 * MiB;
constexpr size_t WS_GA = 338 * MiB, WS_GB = 402 * MiB, WS_LOGF = 466 * MiB;
constexpr size_t WS_PP = 402 * MiB;
constexpr size_t WS_SS = 530 * MiB;
constexpr size_t WS_BAR = 530 * MiB + 512 * 1024;
constexpr size_t WS_END = 531 * MiB;

typedef float f32x2_t __attribute__((ext_vector_type(2))); typedef __bf16 bf16x2_t __attribute__((ext_vector_type(2)));
__device__ __forceinline__ unsigned cvt_pk_bf16(float lo, float hi) { const f32x2_t v = {lo, hi}; const bf16x2_t b = __builtin_convertvector(v, bf16x2_t); return __builtin_bit_cast(unsigned, b); }
__device__ __forceinline__ bf16_t f2bf(float f) { return (bf16_t)(cvt_pk_bf16(f, 0.f) & 0xffffu); }
__device__ __forceinline__ float bf2f(unsigned b) { return __uint_as_float(b << 16); }
__device__ __forceinline__ float bflo(unsigned w) { return __uint_as_float(w << 16); }
__device__ __forceinline__ float bfhi(unsigned w) { return __uint_as_float(w & 0xffff0000u); }
__device__ __forceinline__ float ex2(float x) { return __builtin_amdgcn_exp2f(x); }
__device__ __forceinline__ float rcpf_(float x) { return __builtin_amdgcn_rcpf(x); }
__device__ __forceinline__ float sigm(float x) { return rcpf_(1.f + ex2(-LOG2E * x)); }
__device__ __forceinline__ float silu(float x) { return x * sigm(x); }
__device__ __forceinline__ float wave_sum(float v) {
#pragma unroll
    for (int o = 1; o < 64; o <<= 1) v += __shfl_xor(v, o);
    return v;
}
template <int CTRL> __device__ __forceinline__ float dppmov(float v) { return __int_as_float(__builtin_amdgcn_update_dpp(0, __float_as_int(v), CTRL, 0xF, 0xF, true)); }
__device__ __forceinline__ float grp16_sum(float v) { v += dppmov<0xB1>(v); v += dppmov<0x4E>(v); v += dppmov<0x124>(v); v += dppmov<0x128>(v); return v; }
__device__ __forceinline__ float grp16_max(float v) { v = fmaxf(v, dppmov<0xB1>(v)); v = fmaxf(v, dppmov<0x4E>(v)); v = fmaxf(v, dppmov<0x124>(v)); v = fmaxf(v, dppmov<0x128>(v)); return v; }
#define MFMA16(a, b, c) __builtin_amdgcn_mfma_f32_16x16x32_bf16((a), (b), (c), 0, 0, 0)

namespace pg8 {
constexpr int BM = 256, BK = 64, HALF = 128, HTB = HALF * BK * 2, STAGE_BYTES = 8 * HTB, NXCD = 8, WGM = 8;
__device__ __forceinline__ int lds_byte(int r, int c) { const int st = (r >> 4) * 2 + (c >> 5), rr = r & 15, cc = c & 31, ob = rr * 64 + cc * 2; return st * 1024 + (ob ^ (((ob >> 9) & 1) << 5)); }
__device__ __forceinline__ void stage_rc(int b, int& R, int& C) { const int st = b / 1024, sb = b % 1024, swz = sb ^ (((sb >> 9) & 1) << 5); R = (st >> 1) * 16 + swz / 64; C = (st & 1) * 32 + (swz % 64) / 2; }
__device__ __forceinline__ int perm32(int rho) { const int n = rho >> 4, i = rho & 15; return 8 * (i >> 2) + 4 * n + (i & 3); }
struct Unit { int pm, pn; };
struct Gemm { const bf16_t* A; const bf16_t* Bt; int M, N, K; };
struct StaticOrder {
    int nM, nN, nwg, G, c, wgm;
    __device__ void init(int M, int N, int G_, int c_, int wgm_ = 8) { nM = M / BM; nN = N / BM; nwg = nM * nN; G = G_; c = c_; wgm = wgm_; }
    __device__ bool next(int i, Unit& u) const {
        const long L = (long)i * G + c; if (L >= nwg) return false;
        int wgid = (int)L; { const int q = nwg / NXCD, r = nwg % NXCD, xcd = wgid % NXCD, off = wgid / NXCD; wgid = (xcd < r ? xcd * (q + 1) : r * (q + 1) + (xcd - r) * q) + off; }
        const int nig = wgm * nN, gid = wgid / nig, fm = gid * wgm, gsz = (nM - fm) < wgm ? (nM - fm) : wgm;
        u.pm = fm + ((wgid % nig) % gsz); u.pn = (wgid % nig) / gsz; return true;
    }
};

#ifndef PG8_SP2
#define PG8_SP2 true
#endif
template <class Epi, bool AT = false, bool BT = false, bool SP2 = PG8_SP2>
__device__ __forceinline__ void gemm_phase(LAS unsigned char* lds, const Gemm g, const StaticOrder& S, const Epi& E) {
    const int tid = threadIdx.x, wid = __builtin_amdgcn_readfirstlane(tid >> 6), lane = tid & 63, wr = wid >> 2, wc = wid & 3, fr = lane & 15, fq = lane >> 4;
    int K = g.K; asm volatile("" : "+s"(K));
    const int nt = K / BK;
    unsigned voffA[2], voffB[2];
#pragma unroll
    for (int i = 0; i < 2; ++i) { int R, C; stage_rc(tid * 16 + i * 8192, R, C); const int Rb = Epi::PERM ? ((R & ~31) + perm32(R & 31)) : R;
        voffA[i] = (unsigned)(R * (AT ? 64 : K) + C) * 2u; voffB[i] = (unsigned)(Rb * (BT ? 64 : K) + C) * 2u; }
    const size_t tstep = (size_t)BM * K * 2;
    const size_t kstepA = AT ? (size_t)BM * BK * 2 : (size_t)(BK * 2), kstepB = BT ? (size_t)BM * BK * 2 : (size_t)(BK * 2);
    const size_t hstepA = AT ? (size_t)HALF * BK * 2 : (size_t)HALF * K * 2, hstepB = BT ? (size_t)HALF * BK * 2 : (size_t)HALF * K * 2;
    const unsigned ldsw = (unsigned)wid * 1024u;
    const int aoff = lds_byte(wr * 64 + fr, fq * 8), boff = lds_byte(wc * 32 + fr, fq * 8);
#define PG8_SA(b, h) (((b) * 2 + (h)) * HTB)
#define PG8_SB(b, h) ((4 + (b) * 2 + (h)) * HTB)
#define PG8_STAGE(bufoff, gbase, voff) do { _Pragma("unroll") for (int _i = 0; _i < 2; ++_i) \
        __builtin_amdgcn_global_load_lds((const unsigned*)((const char*)(gbase) + (voff)[_i]), (LAS unsigned*)(lds + (bufoff) + ldsw + _i * 8192), 16, 0, 0); } while (0)
#define PG8_LDA(dst, b, h) do { _Pragma("unroll") for (int m = 0; m < 4; ++m) _Pragma("unroll") for (int k = 0; k < 2; ++k) dst[m][k] = *(const LAS bf16x8*)(lds + PG8_SA(b, h) + aoff + m * 2048 + k * 1024); } while (0)
#define PG8_LDB(dst, b, h) do { _Pragma("unroll") for (int n = 0; n < 2; ++n) _Pragma("unroll") for (int k = 0; k < 2; ++k) dst[n][k] = *(const LAS bf16x8*)(lds + PG8_SB(b, h) + boff + n * 2048 + k * 1024); } while (0)
#define PG8_MMA(ai, bj, At, Bt) do { __builtin_amdgcn_s_setprio(1); _Pragma("unroll") for (int m = 0; m < 4; ++m) _Pragma("unroll") for (int n = 0; n < 2; ++n) _Pragma("unroll") for (int k = 0; k < 2; ++k) \
        acc[ai][bj][m][n] = __builtin_amdgcn_mfma_f32_16x16x32_bf16(Bt[n][k], At[m][k], acc[ai][bj][m][n], 0, 0, 0); __builtin_amdgcn_s_setprio(0); } while (0)
#define PG8_WAIT_V(n) asm volatile("s_waitcnt vmcnt(" #n ")" ::: "memory")
#define PG8_WAIT_L(n) asm volatile("s_waitcnt lgkmcnt(" #n ")" ::: "memory")
#define PG8_BAR __builtin_amdgcn_s_barrier()
#define PG8_SCHED __builtin_amdgcn_sched_barrier(0)
    Unit cur, nxt; int ui = 0;
    if (!S.next(0, cur)) return;
    f32x4 acc[2][2][4][2];
#pragma unroll
    for (int a = 0; a < 2; ++a)
#pragma unroll
        for (int b = 0; b < 2; ++b)
#pragma unroll
            for (int m = 0; m < 4; ++m)
#pragma unroll
                for (int n = 0; n < 2; ++n) acc[a][b][m][n] = (f32x4){0.f, 0.f, 0.f, 0.f};
    bf16x8 At[4][2], B0[2][2], B1[2][2];
    const char* cA = (const char*)g.A + (size_t)cur.pm * tstep; const char* cB = (const char*)g.Bt + (size_t)cur.pn * tstep;
    if (SP2) { PG8_STAGE(PG8_SB(0, 0), cB, voffB); PG8_STAGE(PG8_SB(0, 1), cB + hstepB, voffB); PG8_STAGE(PG8_SA(0, 0), cA, voffA); PG8_STAGE(PG8_SA(0, 1), cA + hstepA, voffA); }
    else { PG8_STAGE(PG8_SB(0, 0), cB, voffB); PG8_STAGE(PG8_SA(0, 0), cA, voffA); PG8_STAGE(PG8_SB(0, 1), cB + hstepB, voffB); PG8_STAGE(PG8_SA(0, 1), cA + hstepA, voffA); }
    if (wr == 1) PG8_BAR;
    if (SP2) PG8_WAIT_V(2); else PG8_WAIT_V(4);
    PG8_BAR;
    PG8_STAGE(PG8_SB(1, 0), cB + kstepB, voffB); PG8_STAGE(PG8_SA(1, 0), cA + kstepA, voffA); PG8_STAGE(PG8_SB(1, 1), cB + hstepB + kstepB, voffB);
    PG8_WAIT_V(6); PG8_BAR;
    for (;;) {
        const bool has_next = S.next(ui + 1, nxt);
        const char* nA = has_next ? (const char*)g.A + (size_t)nxt.pm * tstep : cA; const char* nB = has_next ? (const char*)g.Bt + (size_t)nxt.pn * tstep : cB;
        for (int t = 0; t < nt; t += 2) {
            const bool last = (t == nt - 2);
            const char* a1 = cA + (size_t)(t + 1) * kstepA;
            const char* a2 = last ? nA : cA + (size_t)(t + 2) * kstepA; const char* b2 = last ? nB : cB + (size_t)(t + 2) * kstepB;
            const char* a3 = a2 + kstepA; const char* b3 = b2 + kstepB;
            if constexpr (SP2) {
            PG8_LDB(B0, 0, 0); PG8_LDB(B1, 0, 1); PG8_SCHED; PG8_LDA(At, 0, 0); PG8_STAGE(PG8_SA(1, 1), a1 + hstepA, voffA);
            PG8_WAIT_V(8); PG8_WAIT_L(0); PG8_BAR; PG8_MMA(0, 0, At, B0); PG8_MMA(0, 1, At, B1); PG8_BAR; PG8_SCHED;
            PG8_LDA(At, 0, 1); PG8_STAGE(PG8_SB(0, 0), b2, voffB); PG8_STAGE(PG8_SB(0, 1), b2 + hstepB, voffB); PG8_STAGE(PG8_SA(0, 0), a2, voffA);
            PG8_WAIT_V(8); PG8_WAIT_L(0); PG8_BAR; PG8_MMA(1, 0, At, B0); PG8_MMA(1, 1, At, B1); PG8_BAR; PG8_SCHED;
            PG8_LDB(B0, 1, 0); PG8_LDB(B1, 1, 1); PG8_SCHED; PG8_LDA(At, 1, 0); PG8_STAGE(PG8_SA(0, 1), a2 + hstepA, voffA);
            PG8_WAIT_V(8); PG8_WAIT_L(0); PG8_BAR; PG8_MMA(0, 0, At, B0); PG8_MMA(0, 1, At, B1); PG8_BAR; PG8_SCHED;
            PG8_LDA(At, 1, 1); PG8_STAGE(PG8_SB(1, 0), b3, voffB); PG8_STAGE(PG8_SB(1, 1), b3 + hstepB, voffB); PG8_STAGE(PG8_SA(1, 0), a3, voffA);
            PG8_WAIT_V(8); PG8_WAIT_L(0); PG8_BAR; PG8_MMA(1, 0, At, B0); PG8_MMA(1, 1, At, B1); PG8_BAR; PG8_SCHED;
            } else {
            PG8_LDB(B0, 0, 0); PG8_SCHED; PG8_LDA(At, 0, 0); PG8_STAGE(PG8_SA(1, 1), a1 + hstepA, voffA);
            PG8_WAIT_L(8); PG8_BAR; PG8_WAIT_L(0); PG8_MMA(0, 0, At, B0); PG8_BAR; PG8_SCHED;
            PG8_LDB(B1, 0, 1); PG8_STAGE(PG8_SB(0, 0), b2, voffB);
            PG8_BAR; PG8_WAIT_L(0); PG8_MMA(0, 1, At, B1); PG8_BAR;
            PG8_LDA(At, 0, 1); PG8_STAGE(PG8_SA(0, 0), a2, voffA);
            PG8_BAR; PG8_WAIT_L(0); PG8_MMA(1, 0, At, B0); PG8_BAR; PG8_SCHED;
            PG8_STAGE(PG8_SB(0, 1), b2 + hstepB, voffB);
            PG8_WAIT_V(6); PG8_BAR; PG8_MMA(1, 1, At, B1); PG8_BAR;
            PG8_LDB(B0, 1, 0); PG8_SCHED; PG8_LDA(At, 1, 0); PG8_STAGE(PG8_SA(0, 1), a2 + hstepA, voffA);
            PG8_WAIT_L(8); PG8_BAR; PG8_WAIT_L(0); PG8_MMA(0, 0, At, B0); PG8_BAR; PG8_SCHED;
            PG8_LDB(B1, 1, 1); PG8_STAGE(PG8_SB(1, 0), b3, voffB);
            PG8_BAR; PG8_WAIT_L(0); PG8_MMA(0, 1, At, B1); PG8_BAR;
            PG8_LDA(At, 1, 1); PG8_STAGE(PG8_SA(1, 0), a3, voffA);
            PG8_BAR; PG8_WAIT_L(0); PG8_MMA(1, 0, At, B0); PG8_BAR; PG8_SCHED;
            PG8_STAGE(PG8_SB(1, 1), b3 + hstepB, voffB);
            PG8_WAIT_V(6); PG8_BAR; PG8_MMA(1, 1, At, B1); PG8_BAR;
            }
        }
        if (wr == 0) PG8_BAR;
        E(acc, cur, wr, wc, fr, fq);
        if (!has_next) break;
#pragma unroll
        for (int a = 0; a < 2; ++a)
#pragma unroll
            for (int b = 0; b < 2; ++b)
#pragma unroll
                for (int m = 0; m < 4; ++m)
#pragma unroll
                    for (int n = 0; n < 2; ++n) acc[a][b][m][n] = (f32x4){0.f, 0.f, 0.f, 0.f};
        cur = nxt; cA = nA; cB = nB; ++ui;
        if (wr == 1) PG8_BAR;
    }
    PG8_WAIT_V(0);
    PG8_BAR;
#undef PG8_SA
#undef PG8_SB
#undef PG8_STAGE
#undef PG8_LDA
#undef PG8_LDB
#undef PG8_MMA
#undef PG8_WAIT_V
#undef PG8_WAIT_L
#undef PG8_BAR
#undef PG8_SCHED
}
}
using pg8::Unit;

__device__ __forceinline__ u32x4 pack8(const f32x4 a, const f32x4 b) { u32x4 w; w.x = cvt_pk_bf16(a[0], a[1]); w.y = cvt_pk_bf16(a[2], a[3]); w.z = cvt_pk_bf16(b[0], b[1]); w.w = cvt_pk_bf16(b[2], b[3]); return w; }
__device__ __forceinline__ void unpack8(const u32x4 w, f32x4& a, f32x4& b) { a = (f32x4){bflo(w.x), bfhi(w.x), bflo(w.y), bfhi(w.y)}; b = (f32x4){bflo(w.z), bfhi(w.z), bflo(w.w), bfhi(w.w)}; }

struct EpiSwiGLU {
    static constexpr bool PERM = true;
    bf16_t* O; const float* ss;
    __device__ __forceinline__ void operator()(const f32x4 (&acc)[2][2][4][2], const Unit& u, int wr, int wc, int fr, int fq) const {
        const int rl0 = wr * 64 + fr, kt = u.pn * 2 + (wc >> 1), within = (wc & 1) * 32 + 8 * fq;
        float rsv[2][4];
#pragma unroll
        for (int ai = 0; ai < 2; ++ai)
#pragma unroll
            for (int m = 0; m < 4; ++m) rsv[ai][m] = ss ? ss[u.pm * 256 + rl0 + ai * 128 + m * 16] : 0.f;
#pragma unroll
        for (int ai = 0; ai < 2; ++ai)
#pragma unroll
            for (int m = 0; m < 4; ++m) {
                const float rs = ss ? 1.0f / sqrtf(rsv[ai][m] * (1.f / DM) + EPS) : 1.f;
                f32x4 v0, v1;
#pragma unroll
                for (int j = 0; j < 4; ++j) { v0[j] = silu(acc[ai][0][m][0][j] * rs) * (acc[ai][1][m][0][j] * rs); v1[j] = silu(acc[ai][0][m][1][j] * rs) * (acc[ai][1][m][1][j] * rs); }
                *(u32x4*)(O + ((size_t)u.pm * (FF / 64) + kt) * 16384 + (size_t)(rl0 + ai * 128 + m * 16) * 64 + within) = pack8(v0, v1);
            }
    }
};
struct EpiResid {
    static constexpr bool PERM = false;
    const float* base; float* out; float scale;
    __device__ __forceinline__ void operator()(const f32x4 (&acc)[2][2][4][2], const Unit& u, int wr, int wc, int fr, int fq) const {
        const int row0 = u.pm * 256 + wr * 64 + fr, col0 = u.pn * 256 + wc * 32 + 4 * fq;
#pragma unroll
        for (int ai = 0; ai < 2; ++ai)
#pragma unroll
            for (int m = 0; m < 4; ++m) { const size_t off = (size_t)(row0 + ai * 128 + m * 16) * DM + col0;
#pragma unroll
                for (int bj = 0; bj < 2; ++bj)
#pragma unroll
                    for (int n = 0; n < 2; ++n) { const f32x4 b = *(const f32x4*)(base + off + bj * 128 + n * 16); *(f32x4*)(out + off + bj * 128 + n * 16) = b + scale * acc[ai][bj][m][n]; }
                asm volatile("" ::: "memory"); }
    }
};
struct EpiResidNorm {
    static constexpr bool PERM = false;
    const float* base; float* out; float scale; const float* nw; bf16_t* hb; float* ss;
    __device__ __forceinline__ void operator()(const f32x4 (&acc)[2][2][4][2], const Unit& u, int wr, int wc, int fr, int fq) const {
        const int row0 = u.pm * 256 + wr * 64 + fr, col0 = u.pn * 256 + wc * 32 + 4 * fq;
        f32x4 wv[2][2];
#pragma unroll
        for (int bj = 0; bj < 2; ++bj)
#pragma unroll
            for (int n = 0; n < 2; ++n) wv[bj][n] = *(const f32x4*)(nw + col0 + bj * 128 + n * 16);
        f32x4 pre[2][2][2];
#define ERN_LOAD(g, slot) do { _Pragma("unroll") for (int bj = 0; bj < 2; ++bj) _Pragma("unroll") for (int n = 0; n < 2; ++n) \
        pre[slot][bj][n] = *(const f32x4*)(base + (size_t)(row0 + ((g) >> 2) * 128 + ((g) & 3) * 16) * DM + col0 + bj * 128 + n * 16); } while (0)
        ERN_LOAD(0, 0);
#pragma unroll
        for (int g = 0; g < 8; ++g) { const int ai = g >> 2, m = g & 3, slot = g & 1;
            if (g < 7) { if (slot == 0) ERN_LOAD(g + 1, 1); else ERN_LOAD(g + 1, 0); }
            { const int row = row0 + ai * 128 + m * 16; const size_t off = (size_t)row * DM + col0; float s = 0.f;
#pragma unroll
                for (int bj = 0; bj < 2; ++bj)
#pragma unroll
                    for (int n = 0; n < 2; ++n) { const size_t o = off + bj * 128 + n * 16; const f32x4 r = pre[slot][bj][n] + scale * acc[ai][bj][m][n]; *(f32x4*)(out + o) = r;
                        s += (r[0] * r[0] + r[1] * r[1]) + (r[2] * r[2] + r[3] * r[3]); const f32x4 hv = r * wv[bj][n];
                        u32x2 hw; hw.x = cvt_pk_bf16(hv[0], hv[1]); hw.y = cvt_pk_bf16(hv[2], hv[3]); *(u32x2*)(hb + o) = hw; }
                s += __shfl_xor(s, 16); s += __shfl_xor(s, 32);
                if (fq == 0) __hip_atomic_fetch_add(ss + row, s, __ATOMIC_RELAXED, __HIP_MEMORY_SCOPE_AGENT); }
            asm volatile("" ::: "memory"); }
#undef ERN_LOAD
    }
};
struct EpiPle {
    static constexpr bool PERM = false;
    const float* base; float* out; const bf16_t* pp; const float* ss;
    __device__ __forceinline__ void operator()(const f32x4 (&acc)[2][2][4][2], const Unit& u, int wr, int wc, int fr, int fq) const {
        const int row0 = u.pm * 256 + wr * 64 + fr, col0 = u.pn * 256 + wc * 32 + 4 * fq;
        float rsv[2][4];
#pragma unroll
        for (int ai = 0; ai < 2; ++ai)
#pragma unroll
            for (int m = 0; m < 4; ++m) rsv[ai][m] = ss[row0 + ai * 128 + m * 16];
        f32x4 pb[2][2][2]; u32x2 pw[2][2][2];
#define EPL_LOAD(g, slot) do { _Pragma("unroll") for (int bj = 0; bj < 2; ++bj) _Pragma("unroll") for (int n = 0; n < 2; ++n) { \
        const size_t o_ = (size_t)(row0 + ((g) >> 2) * 128 + ((g) & 3) * 16) * DM + col0 + bj * 128 + n * 16; pb[slot][bj][n] = *(const f32x4*)(base + o_); pw[slot][bj][n] = *(const u32x2*)(pp + o_); } } while (0)
        EPL_LOAD(0, 0);
#pragma unroll
        for (int g = 0; g < 8; ++g) { const int ai = g >> 2, m = g & 3, slot = g & 1;
            if (g < 7) { if (slot == 0) EPL_LOAD(g + 1, 1); else EPL_LOAD(g + 1, 0); }
            const float rs = 1.0f / sqrtf(rsv[ai][m] * (1.f / DM) + EPS);
#pragma unroll
            for (int bj = 0; bj < 2; ++bj)
#pragma unroll
                for (int n = 0; n < 2; ++n) { const size_t o = (size_t)(row0 + ai * 128 + m * 16) * DM + col0 + bj * 128 + n * 16; const u32x2 w2 = pw[slot][bj][n];
                    const f32x4 pv = (f32x4){bflo(w2.x), bfhi(w2.x), bflo(w2.y), bfhi(w2.y)}; f32x4 r;
#pragma unroll
                    for (int j = 0; j < 4; ++j) r[j] = pb[slot][bj][n][j] + sigm(acc[ai][bj][m][n][j] * rs) * pv[j];
                    *(f32x4*)(out + o) = r; }
            asm volatile("" ::: "memory"); }
#undef EPL_LOAD
    }
};
struct EpiPleFinal {
    static constexpr bool PERM = false;
    const float* base; float* out; const bf16_t* pp; const float* ss; float* ss3; unsigned* cnt; const float* fw;
    __device__ __forceinline__ void operator()(f32x4 (&acc)[2][2][4][2], const Unit& u, int wr, int wc, int fr, int fq) const {
        const int row0 = u.pm * 256 + wr * 64 + fr, col0 = u.pn * 256 + wc * 32 + 4 * fq;
        float rsv[2][4];
#pragma unroll
        for (int ai = 0; ai < 2; ++ai)
#pragma unroll
            for (int m = 0; m < 4; ++m) rsv[ai][m] = ss[row0 + ai * 128 + m * 16];
        f32x4 pb[2][2][2]; u32x2 pw[2][2][2];
#define EPF_LOAD(g, slot) do { _Pragma("unroll") for (int bj = 0; bj < 2; ++bj) _Pragma("unroll") for (int n = 0; n < 2; ++n) { \
        const size_t o_ = (size_t)(row0 + ((g) >> 2) * 128 + ((g) & 3) * 16) * DM + col0 + bj * 128 + n * 16; pb[slot][bj][n] = *(const f32x4*)(base + o_); pw[slot][bj][n] = *(const u32x2*)(pp + o_); } } while (0)
        EPF_LOAD(0, 0);
#pragma unroll
        for (int g = 0; g < 8; ++g) { const int ai = g >> 2, m = g & 3, slot = g & 1;
            if (g < 7) { if (slot == 0) EPF_LOAD(g + 1, 1); else EPF_LOAD(g + 1, 0); }
            const float rs = 1.0f / sqrtf(rsv[ai][m] * (1.f / DM) + EPS); float s = 0.f;
#pragma unroll
            for (int bj = 0; bj < 2; ++bj)
#pragma unroll
                for (int n = 0; n < 2; ++n) { const u32x2 w2 = pw[slot][bj][n]; const f32x4 pv = (f32x4){bflo(w2.x), bfhi(w2.x), bflo(w2.y), bfhi(w2.y)}; f32x4 r;
#pragma unroll
                    for (int j = 0; j < 4; ++j) r[j] = pb[slot][bj][n][j] + sigm(acc[ai][bj][m][n][j] * rs) * pv[j];
                    acc[ai][bj][m][n] = r; s += (r[0] * r[0] + r[1] * r[1]) + (r[2] * r[2] + r[3] * r[3]); }
            s += __shfl_xor(s, 16); s += __shfl_xor(s, 32);
            if (fq == 0) __hip_atomic_fetch_add(ss3 + row0 + ai * 128 + m * 16, s, __ATOMIC_RELAXED, __HIP_MEMORY_SCOPE_AGENT); }
#undef EPF_LOAD
        asm volatile("s_waitcnt vmcnt(0) lgkmcnt(0)" ::: "memory"); __builtin_amdgcn_s_barrier(); asm volatile("" ::: "memory");
        if (threadIdx.x == 0) { unsigned* c = cnt + 8 * u.pm; (void)__hip_atomic_fetch_add(c, 1u, __ATOMIC_RELAXED, __HIP_MEMORY_SCOPE_AGENT); unsigned sp = 0u;
            while (__hip_atomic_load(c, __ATOMIC_RELAXED, __HIP_MEMORY_SCOPE_AGENT) < 8u && ++sp < 100000u) __builtin_amdgcn_s_sleep(2);
            __builtin_amdgcn_fence(__ATOMIC_ACQUIRE, "agent"); asm volatile("s_waitcnt vmcnt(0)" ::: "memory"); }
        __builtin_amdgcn_s_barrier(); asm volatile("" ::: "memory");
        f32x4 fwv[2][2];
#pragma unroll
        for (int bj = 0; bj < 2; ++bj)
#pragma unroll
            for (int n = 0; n < 2; ++n) fwv[bj][n] = *(const f32x4*)(fw + col0 + bj * 128 + n * 16);
        float tot[2][4];
#pragma unroll
        for (int ai = 0; ai < 2; ++ai)
#pragma unroll
            for (int m = 0; m < 4; ++m) tot[ai][m] = __hip_atomic_load(ss3 + row0 + ai * 128 + m * 16, __ATOMIC_RELAXED, __HIP_MEMORY_SCOPE_AGENT);
#pragma unroll
        for (int ai = 0; ai < 2; ++ai)
#pragma unroll
            for (int m = 0; m < 4; ++m) { const float rstd = 1.0f / sqrtf(tot[ai][m] * (1.f / DM) + EPS); const size_t off = (size_t)(row0 + ai * 128 + m * 16) * DM + col0;
#pragma unroll
                for (int bj = 0; bj < 2; ++bj)
#pragma unroll
                    for (int n = 0; n < 2; ++n) *(f32x4*)(out + off + bj * 128 + n * 16) = acc[ai][bj][m][n] * rstd * fwv[bj][n]; }
    }
};
template <int MODE> struct EpiBf {
    static constexpr bool PERM = true;
    bf16_t* O; const bf16_t* X;
    __device__ __forceinline__ void operator()(const f32x4 (&acc)[2][2][4][2], const Unit& u, int wr, int wc, int fr, int fq) const {
        const int row0 = u.pm * 256 + wr * 64 + fr, col0 = u.pn * 256 + wc * 32 + 8 * fq;
#pragma unroll
        for (int ai = 0; ai < 2; ++ai) {
            u32x4 po[4][2], px[4][2];
            if (MODE >= 1) {
#pragma unroll
                for (int m = 0; m < 4; ++m)
#pragma unroll
                    for (int bj = 0; bj < 2; ++bj) { const size_t o = (size_t)(row0 + ai * 128 + m * 16) * DM + col0 + bj * 128; po[m][bj] = *(const u32x4*)(O + o); if (MODE == 2) px[m][bj] = *(const u32x4*)(X + o); } }
#pragma unroll
            for (int m = 0; m < 4; ++m)
#pragma unroll
                for (int bj = 0; bj < 2; ++bj) { const size_t o = (size_t)(row0 + ai * 128 + m * 16) * DM + col0 + bj * 128;
                    f32x4 v0 = acc[ai][bj][m][0], v1 = acc[ai][bj][m][1];
                    if (MODE >= 1) { f32x4 g0, g1; unpack8(po[m][bj], g0, g1); v0 = v0 * g0; v1 = v1 * g1; }
                    if (MODE == 2) { f32x4 x0, x1; unpack8(px[m][bj], x0, x1); v0 = v0 + x0; v1 = v1 + x1; }
                    *(u32x4*)(O + o) = pack8(v0, v1); }
            asm volatile("" ::: "memory"); }
    }
};
struct EpiProj {
    static constexpr bool PERM = true;
    bf16_t *Q, *Kk, *V, *QB, *IB, *OG, *GA, *GB; float* LOGF; const float* ropec; const float* ropes; const float* lbp; const float* ss;
    __device__ __forceinline__ void operator()(const f32x4 (&acc)[2][2][4][2], const Unit& u, int wr, int wc, int fr, int fq) const {
        const int pn = u.pn, row0 = u.pm * 256 + wr * 64 + fr, cw = wc * 32 + 8 * fq;
        float rs[2][4];
#pragma unroll
        for (int ai = 0; ai < 2; ++ai)
#pragma unroll
            for (int m = 0; m < 4; ++m) rs[ai][m] = 1.0f / sqrtf(ss[row0 + ai * 128 + m * 16] * (1.f / DM) + EPS);
        if (pn < 5) {
            bf16_t* base = pn < 4 ? Q : Kk; const int ld = pn < 4 ? 1024 : 256, colt = pn < 4 ? pn * 256 : 0; const float sc = pn < 4 ? QSCALE : 1.f;
            const bool ropew = ((wc & 1) == 0) && (fq < 2);
#pragma unroll
            for (int ai = 0; ai < 2; ++ai)
#pragma unroll
              for (int mh = 0; mh < 2; ++mh) {
                f32x4 rc0[2], rc1[2], rs0[2], rs1[2];
#pragma unroll
                for (int ml = 0; ml < 2; ++ml) { const size_t rr = (size_t)(row0 + ai * 128 + (2 * mh + ml) * 16) * 8;
                    rc0[ml] = (f32x4){1.f, 1.f, 1.f, 1.f}; rc1[ml] = rc0[ml]; rs0[ml] = (f32x4){0.f, 0.f, 0.f, 0.f}; rs1[ml] = rs0[ml];
                    if (ropew) { rc0[ml] = *(const f32x4*)(ropec + rr); rc1[ml] = *(const f32x4*)(ropec + rr + 4); rs0[ml] = *(const f32x4*)(ropes + rr); rs1[ml] = *(const f32x4*)(ropes + rr + 4); } }
#pragma unroll
                for (int ml = 0; ml < 2; ++ml) { const int m = 2 * mh + ml; const int row = row0 + ai * 128 + m * 16;
                    f32x4 c0 = rc0[ml], c1 = rc1[ml], s0 = rs0[ml], s1 = rs1[ml];
                    if (ropew && fq == 0) { s0 = -s0; s1 = -s1; }
#pragma unroll
                    for (int bj = 0; bj < 2; ++bj) { f32x4 v0 = acc[ai][bj][m][0] * rs[ai][m], v1 = acc[ai][bj][m][1] * rs[ai][m], p0, p1;
#pragma unroll
                        for (int j = 0; j < 4; ++j) { p0[j] = __shfl_xor(v0[j], 16); p1[j] = __shfl_xor(v1[j], 16); }
                        v0 = (v0 * c0 + p0 * s0) * sc; v1 = (v1 * c1 + p1 * s1) * sc;
                        *(u32x4*)(base + (size_t)row * ld + colt + bj * 128 + cw) = pack8(v0, v1); } }
                asm volatile("" ::: "memory"); }
        } else if (pn >= 10 && pn < 14) {
            const int colt = (pn - 10) * 256;
            f32x4 lb[2][2];
#pragma unroll
            for (int bj = 0; bj < 2; ++bj)
#pragma unroll
                for (int n = 0; n < 2; ++n) { const int c = colt + bj * 128 + cw + 4 * n; const f32x4 a0 = *(const f32x4*)(lbp + c), a1 = *(const f32x4*)(lbp + 1024 + c);
#pragma unroll
                    for (int j = 0; j < 4; ++j) lb[bj][n][j] = rcpf_(1.f + ex2(LOG2E * (a1[j] - a0[j]))); }
#pragma unroll
            for (int ai = 0; ai < 2; ++ai)
#pragma unroll
                for (int m = 0; m < 4; ++m) { const int row = row0 + ai * 128 + m * 16;
#pragma unroll
                    for (int bj = 0; bj < 2; ++bj)
#pragma unroll
                        for (int n = 0; n < 2; ++n) { f32x4 r;
#pragma unroll
                            for (int j = 0; j < 4; ++j) { const float l = lb[bj][n][j]; r[j] = __builtin_amdgcn_logf(l + (1.f - l) * sigm(acc[ai][bj][m][n][j] * rs[ai][m])); }
                            *(f32x4*)(LOGF + (size_t)row * 1024 + colt + bj * 128 + cw + 4 * n) = r; }
                    asm volatile("" ::: "memory"); }
        } else {
            bf16_t* base; int ld, colt, act;
            if (pn == 5) { base = V; ld = 256; colt = 0; act = 0; }
            else if (pn < 10) { base = QB; ld = 1024; colt = (pn - 6) * 256; act = 1; }
            else if (pn < 18) { base = IB; ld = 1024; colt = (pn - 14) * 256; act = 0; }
            else if (pn < 22) { base = OG; ld = 1024; colt = (pn - 18) * 256; act = 1; }
            else if (pn < 30) { base = GA; ld = 2048; colt = (pn - 22) * 256; act = 2; }
            else { base = GB; ld = 2048; colt = (pn - 30) * 256; act = 2; }
#pragma unroll
            for (int ai = 0; ai < 2; ++ai)
#pragma unroll
                for (int m = 0; m < 4; ++m) { const int row = row0 + ai * 128 + m * 16;
#pragma unroll
                    for (int bj = 0; bj < 2; ++bj) { f32x4 v0 = acc[ai][bj][m][0] * rs[ai][m], v1 = acc[ai][bj][m][1] * rs[ai][m];
                        if (act != 0) {
#pragma unroll
                            for (int j = 0; j < 4; ++j) { const float g0 = sigm(v0[j]), g1 = sigm(v1[j]); v0[j] = act == 1 ? v0[j] * g0 : g0; v1[j] = act == 1 ? v1[j] * g1 : g1; } }
                        *(u32x4*)(base + (size_t)row * ld + colt + bj * 128 + cw) = pack8(v0, v1); }
                    asm volatile("" ::: "memory"); }
        }
    }
};

struct Args { const void* in[23]; float* out; unsigned char* ws; int ph_lo, ph_hi; };

struct Ctx { LAS unsigned char* lds; int tid, lane, wave, G, bid; };

__device__ __forceinline__ void conv_matrix(const Ctx& C, const float* W, int K, int N, bf16_t* WT, int blk, int stride, int off, bool tiled = false) {
    LAS float* scr = (LAS float*)(C.lds + C.wave * 16384);
    const int gw = C.bid * NWAVES + C.wave, NGW = C.G * NWAVES, nblk = N / 32, nitems = (K / 64) * nblk, lane = C.lane;
    for (int item = gw; item < nitems; item += NGW) {
        const int kb = item / nblk, nb = item % nblk, k0 = 64 * kb, n0 = 32 * nb;
        float wv_[32];
#pragma unroll
        for (int i = 0; i < 32; ++i) wv_[i] = W[(size_t)(k0 + 2 * i + (lane >> 5)) * N + n0 + (lane & 31)];
#pragma unroll
        for (int i = 0; i < 32; ++i) scr[(2 * i + (lane >> 5)) * 33 + (lane & 31)] = wv_[i];
        asm volatile("s_waitcnt lgkmcnt(0)" ::: "memory");
        const int c = lane & 7;
#pragma unroll
        for (int j = 0; j < 4; ++j) { const int n = (lane >> 3) + 8 * j; const LAS float* s = scr + (8 * c) * 33 + n;
            u32x4 o; o.x = cvt_pk_bf16(s[0 * 33], s[1 * 33]); o.y = cvt_pk_bf16(s[2 * 33], s[3 * 33]); o.z = cvt_pk_bf16(s[4 * 33], s[5 * 33]); o.w = cvt_pk_bf16(s[6 * 33], s[7 * 33]);
            const int ng = n0 + n, drow = (ng / blk) * stride + off + (ng % blk);
            const size_t dst = tiled ? ((size_t)(drow >> 8) * (K >> 6) + (k0 >> 6)) * 16384 + (size_t)(drow & 255) * 64 + 8 * c : (size_t)drow * K + k0 + 8 * c;
            *(u32x4*)(WT + dst) = o; }
        asm volatile("s_waitcnt lgkmcnt(0)" ::: "memory");
    }
}
__device__ __forceinline__ void norm_rows_bf16(const Ctx& C, const float* X, const float* w, bf16_t* O) {
    const int gw = C.bid * NWAVES + C.wave, NGW = C.G * NWAVES, lane = C.lane;
    f32x4 wv[8];
#pragma unroll
    for (int j = 0; j < 8; ++j) wv[j] = *(const f32x4*)(w + 4 * lane + 256 * j);
    for (int m = gw; m < T; m += NGW) {
        const float* xr = X + (size_t)m * DM + 4 * lane; f32x4 v[8]; float s = 0.f;
#pragma unroll
        for (int j = 0; j < 8; ++j) { v[j] = *(const f32x4*)(xr + 256 * j); s += (v[j][0] * v[j][0] + v[j][1] * v[j][1]) + (v[j][2] * v[j][2] + v[j][3] * v[j][3]); }
        const float rstd = 1.0f / sqrtf(wave_sum(s) * (1.f / DM) + EPS);
        bf16_t* orow = O + (size_t)m * DM + 4 * lane;
#pragma unroll
        for (int j = 0; j < 8; ++j) { const f32x4 r = v[j] * rstd * wv[j]; u32x2 o; o.x = cvt_pk_bf16(r[0], r[1]); o.y = cvt_pk_bf16(r[2], r[3]); *(u32x2*)(orow + 256 * j) = o; }
    }
}
__device__ __forceinline__ void norm_rows_f32_inplace(const Ctx& C, float* X, const float* w) {
    const int gw = C.bid * NWAVES + C.wave, NGW = C.G * NWAVES, lane = C.lane;
    f32x4 wv[8];
#pragma unroll
    for (int j = 0; j < 8; ++j) wv[j] = *(const f32x4*)(w + 4 * lane + 256 * j);
    for (int m = gw; m < T; m += NGW) {
        float* xr = X + (size_t)m * DM + 4 * lane; f32x4 v[8]; float s = 0.f;
#pragma unroll
        for (int j = 0; j < 8; ++j) { v[j] = *(const f32x4*)(xr + 256 * j); s += (v[j][0] * v[j][0] + v[j][1] * v[j][1]) + (v[j][2] * v[j][2] + v[j][3] * v[j][3]); }
        const float rstd = 1.0f / sqrtf(wave_sum(s) * (1.f / DM) + EPS);
#pragma unroll
        for (int j = 0; j < 8; ++j) *(f32x4*)(xr + 256 * j) = v[j] * rstd * wv[j];
    }
}
__device__ __forceinline__ void rope_tables(const Ctx& C, const int* positions, float* rc, float* rs) {
    const float invf[8] = {1.0f, 0.1939227432012558f, 0.03760603070259094f, 0.007292664609849453f, 0.0014142135623842478f, 0.00027424818836152554f, 5.318296098266728e-05f, 1.0313386155758053e-05f};
    for (int idx = C.bid * NTHREADS + C.tid; idx < T * 8; idx += C.G * NTHREADS) {
        const int t = idx >> 3, i = idx & 7;
        float f = invf[0];
#pragma unroll
        for (int k = 1; k < 8; ++k) f = (i == k) ? invf[k] : f;
        const float ang = (float)positions[t] * f;
        double rev = (double)ang * 0.15915494309189535; rev -= __builtin_rint(rev);
        const float r = (float)rev;
        rc[idx] = __builtin_amdgcn_cosf(r); rs[idx] = __builtin_amdgcn_sinf(r);
    }
}
__device__ __forceinline__ void conv_p(const Ctx& C, const float* p, bf16_t* pb) {
    for (size_t i = (size_t)(C.bid * NTHREADS + C.tid) * 8; i < (size_t)T * PLE; i += (size_t)C.G * NTHREADS * 8) {
        const f32x4 a = *(const f32x4*)(p + i), b = *(const f32x4*)(p + i + 4); *(u32x4*)(pb + i) = pack8(a, b); }
}

__device__ __forceinline__ void attn_phase(const Ctx& C, const bf16_t* Q, const bf16_t* K, const bf16_t* V, const float* sinks, bf16_t* O) {
    const int tid = C.tid, lane = C.lane, w = C.wave, fr = lane & 15, fq = lane >> 4;
    LAS bf16_t* Ks = (LAS bf16_t*)C.lds;
    LAS bf16_t* Vt = (LAS bf16_t*)(C.lds + 36864);
    LAS bf16_t* Pw = (LAS bf16_t*)(C.lds + 36864 + 33792 + w * 8448);
    for (int unit = C.bid; unit < 512; unit += C.G) {
        const int n = unit & 31, kvh = (unit >> 5) & 3, b = unit >> 7;
        u32x4 kq[4], vq[4];
#pragma unroll
        for (int i = 0; i < 4; ++i) { const int ch = tid + 512 * i, j = ch >> 3, c8 = (ch & 7) * 8, pos = (n - 1) * 128 + j, posc = pos < 0 ? 0 : pos;
            const size_t g = ((size_t)(b * SEQ + posc)) * 256 + kvh * 64 + c8; kq[i] = *(const u32x4*)(K + g); vq[i] = *(const u32x4*)(V + g); }
        bf16x8 qfa[4][2]; float sk[4];
#pragma unroll
        for (int g = 0; g < 4; ++g) { const bf16_t* qp = Q + (size_t)(b * SEQ + n * 128 + 16 * w + fr) * 1024 + (kvh * 4 + g) * 64 + 8 * fq;
            qfa[g][0] = *(const bf16x8*)qp; qfa[g][1] = *(const bf16x8*)(qp + 32); sk[g] = sinks[kvh * 4 + g]; }
        __syncthreads();
#pragma unroll
        for (int i = 0; i < 4; ++i) {
            const int ch = tid + 512 * i, j = ch >> 3, c8 = (ch & 7) * 8, pos = (n - 1) * 128 + j;
            u32x4 kv = kq[i], vv = vq[i];
            if (pos < 0) { kv = (u32x4){0u, 0u, 0u, 0u}; vv = kv; }
            *(LAS u32x4*)(Ks + j * 72 + c8) = kv;
            Vt[(c8 + 0) * 264 + j] = (bf16_t)(vv.x & 0xffffu); Vt[(c8 + 1) * 264 + j] = (bf16_t)(vv.x >> 16);
            Vt[(c8 + 2) * 264 + j] = (bf16_t)(vv.y & 0xffffu); Vt[(c8 + 3) * 264 + j] = (bf16_t)(vv.y >> 16);
            Vt[(c8 + 4) * 264 + j] = (bf16_t)(vv.z & 0xffffu); Vt[(c8 + 5) * 264 + j] = (bf16_t)(vv.z >> 16);
            Vt[(c8 + 6) * 264 + j] = (bf16_t)(vv.w & 0xffffu); Vt[(c8 + 7) * 264 + j] = (bf16_t)(vv.w >> 16);
        }
        __syncthreads();
        const int t0 = w & ~1;
#pragma unroll
        for (int g = 0; g < 4; ++g) {
            const int head = kvh * 4 + g;
            const bf16x8 qf0 = qfa[g][0], qf1 = qfa[g][1];
            f32x4 s[10];
            {
                bf16x8 kf[10][2];
#pragma unroll
                for (int i = 0; i < 10; ++i) { const LAS bf16_t* kp = Ks + (16 * (t0 + i) + fr) * 72 + 8 * fq; kf[i][0] = *(const LAS bf16x8*)kp; kf[i][1] = *(const LAS bf16x8*)(kp + 32); }
                __builtin_amdgcn_sched_barrier(0);
#pragma unroll
                for (int i = 0; i < 10; ++i) { f32x4 a = {0.f, 0.f, 0.f, 0.f}; a = MFMA16(qf0, kf[i][0], a); a = MFMA16(qf1, kf[i][1], a); s[i] = a; }
            }
            const float sink2 = sk[g] * LOG2E;
            float mx[4] = {sink2, sink2, sink2, sink2};
#pragma unroll
            for (int i = 0; i < 10; ++i)
#pragma unroll
                for (int r = 0; r < 4; ++r) { const int j = 16 * (t0 + i) + fr, dist = 16 * w + 4 * fq + r + 128 - j;
                    const bool ok = (dist >= 0) && (dist < 128) && (n > 0 || j >= 128);
                    const float v = ok ? s[i][r] : -INFINITY; s[i][r] = v; mx[r] = fmaxf(mx[r], v); if (r == 3) __builtin_amdgcn_sched_barrier(0); }
            float sum[4], inv[4];
#pragma unroll
            for (int r = 0; r < 4; ++r) { mx[r] = grp16_max(mx[r]); sum[r] = 0.f; }
#pragma unroll
            for (int i = 0; i < 10; ++i)
#pragma unroll
                for (int r = 0; r < 4; ++r) { const float e = ex2(s[i][r] - mx[r]); s[i][r] = e; sum[r] += e; }
#pragma unroll
            for (int r = 0; r < 4; ++r) { sum[r] = grp16_sum(sum[r]) + ex2(sink2 - mx[r]); inv[r] = 1.0f / sum[r]; }
#pragma unroll
            for (int i = 0; i < 10; ++i)
#pragma unroll
                for (int r = 0; r < 4; ++r) Pw[(4 * fq + r) * 264 + 16 * (t0 + i) + fr] = f2bf(s[i][r] * inv[r]);
            asm volatile("s_waitcnt lgkmcnt(0)" ::: "memory");
            f32x4 o[4];
#pragma unroll
            for (int dt = 0; dt < 4; ++dt) o[dt] = (f32x4){0.f, 0.f, 0.f, 0.f};
            {
                bf16x8 pa[5], vf[5][4];
#pragma unroll
                for (int ks = 0; ks < 5; ++ks) { pa[ks] = *(const LAS bf16x8*)(Pw + fr * 264 + 16 * t0 + 32 * ks + 8 * fq);
#pragma unroll
                    for (int dt = 0; dt < 4; ++dt) vf[ks][dt] = *(const LAS bf16x8*)(Vt + (16 * dt + fr) * 264 + 16 * t0 + 32 * ks + 8 * fq); }
                __builtin_amdgcn_sched_barrier(0);
#pragma unroll
                for (int ks = 0; ks < 5; ++ks)
#pragma unroll
                    for (int dt = 0; dt < 4; ++dt) o[dt] = MFMA16(pa[ks], vf[ks][dt], o[dt]);
            }
#pragma unroll
            for (int dt = 0; dt < 4; ++dt)
#pragma unroll
                for (int r = 0; r < 4; ++r) Pw[(4 * fq + r) * 264 + 16 * dt + fr] = f2bf(o[dt][r]);
            asm volatile("s_waitcnt lgkmcnt(0)" ::: "memory");
            { const int orow = lane >> 2, oc = (lane & 3) * 16;
              const u32x4 w0 = *(const LAS u32x4*)(Pw + orow * 264 + oc), w1 = *(const LAS u32x4*)(Pw + orow * 264 + oc + 8);
              bf16_t* op = O + (size_t)(b * SEQ + n * 128 + 16 * w + orow) * 1024 + head * 64 + oc;
              *(u32x4*)op = w0; *(u32x4*)(op + 8) = w1; }
            asm volatile("s_waitcnt lgkmcnt(0)" ::: "memory");
        }
    }
}

#define HG_CUMSUM(LOGF, row0, h, TOT) \
    const int d = tid & 127, part = tid >> 7; float lf[16], cu[16]; \
    { float run = 0.f; _Pragma("unroll") for (int i = 0; i < 16; ++i) { lf[i] = LOGF[(size_t)(row0 + 16 * part + i) * 1024 + h * 128 + d]; run += lf[i]; cu[i] = run; } \
      TOT[part * 128 + d] = run; } \
    __syncthreads(); \
    float last, pre = 0.f; { const float t0_ = TOT[d], t1_ = TOT[128 + d], t2_ = TOT[256 + d], t3_ = TOT[384 + d]; last = (t0_ + t1_) + (t2_ + t3_); \
      pre = part == 0 ? 0.f : (part == 1 ? t0_ : (part == 2 ? t0_ + t1_ : (t0_ + t1_) + t2_)); } \
    _Pragma("unroll") for (int i = 0; i < 16; ++i) cu[i] += pre;

__device__ __forceinline__ void pack16_store(LAS bf16_t* dst, const float (&v)[16]) {
    u32x4 a, b; a.x = cvt_pk_bf16(v[0], v[1]); a.y = cvt_pk_bf16(v[2], v[3]); a.z = cvt_pk_bf16(v[4], v[5]); a.w = cvt_pk_bf16(v[6], v[7]);
    b.x = cvt_pk_bf16(v[8], v[9]); b.y = cvt_pk_bf16(v[10], v[11]); b.z = cvt_pk_bf16(v[12], v[13]); b.w = cvt_pk_bf16(v[14], v[15]);
    *(LAS u32x4*)dst = a; *(LAS u32x4*)(dst + 8) = b;
}
__device__ __forceinline__ void hgrn_pass1(const Ctx& C, const float* LOGF, const bf16_t* IB, bf16_t* STATE, float* DECAY) {
    const int tid = C.tid, lane = C.lane, w = C.wave, fr = lane & 15, fq = lane >> 4;
    LAS bf16_t* KbT = (LAS bf16_t*)C.lds;
    LAS bf16_t* VT = (LAS bf16_t*)(C.lds + 18432);
    LAS float* TOT = (LAS float*)(C.lds + 36864);
    for (int unit = C.bid; unit < 2048; unit += C.G) {
        const int b = unit >> 9, h = (unit >> 6) & 7, c = unit & 63, row0 = b * SEQ + c * 64;
        __syncthreads();
        HG_CUMSUM(LOGF, row0, h, TOT)
        float kb[16], vv[16];
#pragma unroll
        for (int i = 0; i < 16; ++i) { kb[i] = (1.f - ex2(lf[i])) * ex2(last - cu[i]); vv[i] = bf2f(IB[(size_t)(row0 + 16 * part + i) * 1024 + h * 128 + d]); }
        pack16_store(KbT + d * 72 + 16 * part, kb); pack16_store(VT + d * 72 + 16 * part, vv);
        if (part == 0) DECAY[(size_t)unit * 128 + d] = ex2(last);
        __syncthreads();
        bf16x8 a0 = *(const LAS bf16x8*)(KbT + (16 * w + fr) * 72 + 8 * fq), a1 = *(const LAS bf16x8*)(KbT + (16 * w + fr) * 72 + 32 + 8 * fq);
        bf16x8 vb[8][2];
#pragma unroll
        for (int et = 0; et < 8; ++et) { vb[et][0] = *(const LAS bf16x8*)(VT + (16 * et + fr) * 72 + 8 * fq); vb[et][1] = *(const LAS bf16x8*)(VT + (16 * et + fr) * 72 + 32 + 8 * fq); }
        __builtin_amdgcn_sched_barrier(0);
#pragma unroll
        for (int et = 0; et < 8; ++et) { f32x4 acc = {0.f, 0.f, 0.f, 0.f};
            acc = MFMA16(a0, vb[et][0], acc); acc = MFMA16(a1, vb[et][1], acc);
            u32x2 o; o.x = cvt_pk_bf16(acc[0], acc[1]); o.y = cvt_pk_bf16(acc[2], acc[3]);
            *(u32x2*)(STATE + (size_t)unit * 16384 + (16 * et + fr) * 128 + 16 * w + 4 * fq) = o; }
    }
}
__device__ __forceinline__ void hgrn_pass2(const Ctx& C, bf16_t* STATE, const float* DECAY) {
    for (int idx = C.bid * NTHREADS + C.tid; idx < 32 * 4096; idx += C.G * NTHREADS) {
        const int bh = idx >> 12, el = (idx & 4095) * 4; f32x4 s = {0.f, 0.f, 0.f, 0.f};
#pragma unroll 4
        for (int c = 0; c < 64; ++c) { const size_t unit = (size_t)bh * 64 + c; bf16_t* p = STATE + unit * 16384 + el;
            const u32x2 raw = *(const u32x2*)p; const f32x4 dec = *(const f32x4*)(DECAY + unit * 128 + (el & 127));
            u32x2 o; o.x = cvt_pk_bf16(s[0], s[1]); o.y = cvt_pk_bf16(s[2], s[3]); *(u32x2*)p = o;
            const f32x4 dl = (f32x4){bflo(raw.x), bfhi(raw.x), bflo(raw.y), bfhi(raw.y)}; s = dec * s + dl; }
    }
}
__device__ __forceinline__ void hgrn_pass3(const Ctx& C, const float* LOGF, const bf16_t* QB, const bf16_t* IB, const bf16_t* OG, const bf16_t* STATE, const float* hnorm, bf16_t* OUTB) {
    const int tid = C.tid, lane = C.lane, w = C.wave, fr = lane & 15, fq = lane >> 4;
    LAS bf16_t* Qt = (LAS bf16_t*)C.lds;
    LAS bf16_t* Kt = (LAS bf16_t*)(C.lds + 17408);
    LAS bf16_t* VT = (LAS bf16_t*)(C.lds + 34816);
    LAS bf16_t* ST = (LAS bf16_t*)(C.lds + 53248);
    LAS bf16_t* Am = (LAS bf16_t*)(C.lds + 88064);
    LAS float* TOT = (LAS float*)(C.lds + 97280);
    LAS float* SSQ = (LAS float*)(C.lds + 99328);
    for (int unit = C.bid; unit < 2048; unit += C.G) {
        const int b = unit >> 9, h = (unit >> 6) & 7, c = unit & 63, row0 = b * SEQ + c * 64;
        const int tt = w >> 1;
        float hn[4]; unsigned ogr[4][4];
#pragma unroll
        for (int j = 0; j < 4; ++j) hn[j] = hnorm[h * 128 + 16 * (4 * (w & 1) + j) + fr];
#pragma unroll
        for (int r = 0; r < 4; ++r)
#pragma unroll
            for (int j = 0; j < 4; ++j) ogr[r][j] = OG[(size_t)(row0 + 16 * tt + 4 * fq + r) * 1024 + h * 128 + 16 * (4 * (w & 1) + j) + fr];
        __syncthreads();
        {
            HG_CUMSUM(LOGF, row0, h, TOT)
            float vv[16];
#pragma unroll
            for (int i = 0; i < 16; ++i) { const size_t g = (size_t)(row0 + 16 * part + i) * 1024 + h * 128 + d;
                const float qs = bf2f(QB[g]); vv[i] = bf2f(IB[g]);
                Qt[(16 * part + i) * 136 + d] = f2bf(qs * ex2(cu[i])); Kt[(16 * part + i) * 136 + d] = f2bf((1.f - ex2(lf[i])) * ex2(-cu[i])); }
            pack16_store(VT + d * 72 + 16 * part, vv);
#pragma unroll
            for (int i = 0; i < 4; ++i) { const int ch = tid + 512 * i, e = ch >> 4, c8 = (ch & 15) * 8; *(LAS u32x4*)(ST + e * 136 + c8) = *(const u32x4*)(STATE + (size_t)unit * 16384 + e * 128 + c8); }
        }
        __syncthreads();
        {
            bf16x8 qa[4];
#pragma unroll
            for (int ks = 0; ks < 4; ++ks) qa[ks] = *(const LAS bf16x8*)(Qt + (16 * tt + fr) * 136 + 32 * ks + 8 * fq);
            bf16x8 kb2[2][4];
#pragma unroll
            for (int s2 = 0; s2 < 2; ++s2)
#pragma unroll
                for (int ks = 0; ks < 4; ++ks) kb2[s2][ks] = *(const LAS bf16x8*)(Kt + (16 * (2 * (w & 1) + s2) + fr) * 136 + 32 * ks + 8 * fq);
            __builtin_amdgcn_sched_barrier(0);
#pragma unroll
            for (int s2 = 0; s2 < 2; ++s2) { const int st = 2 * (w & 1) + s2; f32x4 acc = {0.f, 0.f, 0.f, 0.f};
#pragma unroll
                for (int ks = 0; ks < 4; ++ks) acc = MFMA16(qa[ks], kb2[s2][ks], acc);
#pragma unroll
                for (int r = 0; r < 4; ++r) { const int t = 16 * tt + 4 * fq + r, s = 16 * st + fr; Am[t * 72 + s] = f2bf(s <= t ? acc[r] : 0.f); } }
        }
        __syncthreads();
        f32x4 o[4]; float pr[4] = {0.f, 0.f, 0.f, 0.f};
        {
            bf16x8 am[2], qa[4];
#pragma unroll
            for (int ks = 0; ks < 2; ++ks) am[ks] = *(const LAS bf16x8*)(Am + (16 * tt + fr) * 72 + 32 * ks + 8 * fq);
#pragma unroll
            for (int ks = 0; ks < 4; ++ks) qa[ks] = *(const LAS bf16x8*)(Qt + (16 * tt + fr) * 136 + 32 * ks + 8 * fq);
            bf16x8 vtf[4][2], stf[4][4];
#pragma unroll
            for (int j = 0; j < 4; ++j) { const int et = 4 * (w & 1) + j;
#pragma unroll
                for (int ks = 0; ks < 2; ++ks) vtf[j][ks] = *(const LAS bf16x8*)(VT + (16 * et + fr) * 72 + 32 * ks + 8 * fq);
#pragma unroll
                for (int ks = 0; ks < 4; ++ks) stf[j][ks] = *(const LAS bf16x8*)(ST + (16 * et + fr) * 136 + 32 * ks + 8 * fq); }
            __builtin_amdgcn_sched_barrier(0);
#pragma unroll
            for (int j = 0; j < 4; ++j) { f32x4 acc = {0.f, 0.f, 0.f, 0.f};
#pragma unroll
                for (int ks = 0; ks < 2; ++ks) acc = MFMA16(am[ks], vtf[j][ks], acc);
#pragma unroll
                for (int ks = 0; ks < 4; ++ks) acc = MFMA16(qa[ks], stf[j][ks], acc);
                o[j] = acc;
#pragma unroll
                for (int r = 0; r < 4; ++r) pr[r] += acc[r] * acc[r]; }
        }
#pragma unroll
        for (int r = 0; r < 4; ++r) { pr[r] = grp16_sum(pr[r]); if (fr == 0) SSQ[(16 * tt + 4 * fq + r) * 2 + (w & 1)] = pr[r]; }
        __syncthreads();
        LAS bf16_t* Ow = (LAS bf16_t*)(C.lds + 100352 + w * 2304);
#pragma unroll
        for (int r = 0; r < 4; ++r) { const int t = 16 * tt + 4 * fq + r; const float rstd = 1.0f / sqrtf((SSQ[t * 2] + SSQ[t * 2 + 1]) * (1.f / 128.f) + EPS);
#pragma unroll
            for (int j = 0; j < 4; ++j) Ow[(4 * fq + r) * 72 + 16 * j + fr] = f2bf(o[j][r] * rstd * hn[j] * bf2f(ogr[r][j])); }
        asm volatile("s_waitcnt lgkmcnt(0)" ::: "memory");
        { const int orow = lane >> 2, oc = (lane & 3) * 16;
          const u32x4 w0 = *(const LAS u32x4*)(Ow + orow * 72 + oc), w1 = *(const LAS u32x4*)(Ow + orow * 72 + oc + 8);
          bf16_t* op = OUTB + (size_t)(row0 + 16 * tt + orow) * 1024 + h * 128 + 64 * (w & 1) + oc;
          *(u32x4*)op = w0; *(u32x4*)(op + 8) = w1; }
    }
}


#define XB_TMO      128
#define XB_XCNT(j)  (256  + 64 * (j))
#define XB_XSUB(j)  (1280 + 64 * (j))
#define XB_XGEN(j)  (2304 + 64 * (j))
#define XB_TOP      3328
#define XB_TOPGEN   3392
#define XCD_BAR_WORDS 3456
#define XB_SPIN_CAP (1u << 18)
__device__ __forceinline__ unsigned xb_ld(unsigned* p)              { return __hip_atomic_load(p, __ATOMIC_RELAXED, __HIP_MEMORY_SCOPE_AGENT); }
__device__ __forceinline__ unsigned xb_add(unsigned* p, unsigned v) { return __hip_atomic_fetch_add(p, v, __ATOMIC_RELAXED, __HIP_MEMORY_SCOPE_AGENT); }
__device__ __forceinline__ unsigned xb_xcc_id() { return (unsigned)__builtin_amdgcn_s_getreg((3 << 11) | 20) & 0xFu; }
#define XB_SPIN(cond, bar) do { unsigned _sp = 0; while (cond) { __builtin_amdgcn_s_sleep(1); \
    if ((++_sp & 255u) == 0u) { if (xb_ld(&(bar)[XB_TMO])) break; if (_sp > XB_SPIN_CAP) { atomicAdd(&(bar)[XB_TMO], 1u); break; } } } } while (0)
struct XcdBarrier { unsigned* bar; unsigned x; volatile LAS unsigned* st; };
__device__ __forceinline__ XcdBarrier xcd_barrier_post(unsigned* bar, volatile LAS unsigned* st) {
    XcdBarrier b; b.bar = bar; b.x = xb_xcc_id(); b.st = st;
    if (threadIdx.x == 0) st[2] = xb_add(&bar[XB_XCNT(b.x)], 1u);
    return b;
}
__device__ __forceinline__ void xcd_barrier_complete(unsigned* bar, unsigned x, unsigned& nloc, unsigned& nx) {
    const unsigned G = gridDim.x * gridDim.y * gridDim.z;
    unsigned sum, cnt, mine, sp = 0u;
    for (;;) {
        sum = 0u; cnt = 0u; mine = 0u;
#pragma unroll
        for (unsigned j = 0; j < 16; ++j) { const unsigned c = xb_ld(&bar[XB_XCNT(j)]); sum += c; cnt += (c > 0u) ? 1u : 0u; mine = (j == x) ? c : mine; }
        if (sum == G) break;
        __builtin_amdgcn_s_sleep(1);
        if ((++sp & 255u) == 0u) { if (xb_ld(&bar[XB_TMO])) break; if (sp > XB_SPIN_CAP) { atomicAdd(&bar[XB_TMO], 1u); break; } }
    }
    nloc = mine > 0u ? mine : 1u; nx = cnt > 0u ? cnt : 1u;
}
__device__ __forceinline__ void xcd_barrier(const XcdBarrier& b) {
    asm volatile("s_waitcnt vmcnt(0)" ::: "memory");
    __syncthreads();
    if (threadIdx.x == 0) {
        unsigned* bar = b.bar;
        __builtin_amdgcn_s_waitcnt(0);
        unsigned nloc = b.st[0], nx = b.st[1];
        if (nloc == 0u) { xcd_barrier_complete(bar, b.x, nloc, nx); b.st[0] = nloc; b.st[1] = nx; }
        const unsigned old = xb_add(&bar[XB_XSUB(b.x)], 1u);
        const unsigned gen = old / nloc;
        if (old + 1u == (gen + 1u) * nloc) {
            __builtin_amdgcn_fence(__ATOMIC_RELEASE, "agent");
            asm volatile("s_waitcnt vmcnt(0)" ::: "memory");
            const unsigned og = xb_add(&bar[XB_TOP], 1u);
            const unsigned tg = og / nx;
            if (og + 1u == (tg + 1u) * nx) xb_add(&bar[XB_TOPGEN], 1u);
            else XB_SPIN(xb_ld(&bar[XB_TOPGEN]) == tg, bar);
            __builtin_amdgcn_fence(__ATOMIC_ACQUIRE, "agent");
            xb_add(&bar[XB_XGEN(b.x)], 1u);
            asm volatile("s_waitcnt vmcnt(0)" ::: "memory");
        } else {
            XB_SPIN(xb_ld(&bar[XB_XGEN(b.x)]) == gen, bar);
            __builtin_amdgcn_fence(__ATOMIC_ACQUIRE, "agent");
            asm volatile("s_waitcnt vmcnt(0)" ::: "memory");
        }
    }
    __syncthreads();
}
__global__ void __launch_bounds__(NTHREADS, 2) mega_fwd(Args args) {
    extern __shared__ __attribute__((aligned(16))) unsigned char lds_raw[];
    cg::grid_group grid = cg::this_grid();
    Ctx C; C.lds = (LAS unsigned char*)lds_raw; C.tid = threadIdx.x; C.lane = C.tid & 63; C.wave = __builtin_amdgcn_readfirstlane(C.tid >> 6); C.G = gridDim.x; C.bid = blockIdx.x;
    unsigned char* const ws = args.ws;
#define PX ((const float*)args.in[0])
#define POUT (args.out)
#define P_ROPEC ((float*)(ws + WS_ROPE))
#define P_ROPES ((float*)(ws + WS_ROPE) + T * 8)
#define WGU ((bf16_t*)(ws + WS_WA_GU))
#define WD ((bf16_t*)(ws + WS_WA_D))
#define WIN ((bf16_t*)(ws + WS_WIN))
#define WUA ((bf16_t*)(ws + WS_WUA))
#define WUB ((bf16_t*)(ws + WS_WUB))
#define WOUT ((bf16_t*)(ws + WS_WOUT))
#define WPG ((bf16_t*)(ws + WS_WPG))
#define WPP ((bf16_t*)(ws + WS_WPP))
#define H ((bf16_t*)(ws + WS_H))
#define ACT ((bf16_t*)(ws + WS_ACT))
#define Qb ((bf16_t*)(ws + WS_Q))
#define Kb ((bf16_t*)(ws + WS_K))
#define Vb ((bf16_t*)(ws + WS_V))
#define QB ((bf16_t*)(ws + WS_QB))
#define IB ((bf16_t*)(ws + WS_IB))
#define OG ((bf16_t*)(ws + WS_OG))
#define GA ((bf16_t*)(ws + WS_GA))
#define GB ((bf16_t*)(ws + WS_GB))
#define LOGF ((float*)(ws + WS_LOGF))
#define OUTA ((bf16_t*)(ws + WS_OUTA))
#define OUTB ((bf16_t*)(ws + WS_OUTB))
#define STATE ((bf16_t*)(ws + WS_STATE))
#define DECAY ((float*)(ws + WS_DECAY))
#define PBF ((bf16_t*)(ws + WS_PBF))
#define PP ((bf16_t*)(ws + WS_PP))
#define SSQ0 ((float*)(ws + WS_SS))
    volatile LAS unsigned* xst = (volatile LAS unsigned*)(C.lds + LDS_BYTES - 64);
    if (C.tid < 4) xst[C.tid] = 0u;
    __syncthreads();
    if (args.ph_hi - args.ph_lo > 1) {
        if (C.bid == 0) { unsigned* bw = (unsigned*)(ws + WS_BAR); for (int i = C.tid; i < 4096; i += NTHREADS) bw[i] = 0u; }
        asm volatile("s_waitcnt vmcnt(0)" ::: "memory");
        grid.sync(); }
    const XcdBarrier xbar = xcd_barrier_post((unsigned*)(ws + WS_BAR), xst);
    const int lo = args.ph_lo, hi = args.ph_hi;
#ifndef PHASE_MASK
#define PHASE_MASK 0xffff
#endif
#define IN(k) ((((PHASE_MASK) >> (k)) & 1) && lo <= (k) && (k) < hi)
#define SEAM(k) do { if (IN(k) && IN((k) + 1)) { asm volatile("s_waitcnt vmcnt(0) lgkmcnt(0)" ::: "memory"); xcd_barrier(xbar); } } while (0)
    pg8::StaticOrder S;

    if (IN(0)) {
        for (int i = C.bid * NTHREADS + C.tid; i < 4 * T; i += C.G * NTHREADS) SSQ0[i] = 0.f;
        conv_matrix(C, (const float*)args.in[4], DM, FF, WGU, 128, 256, 0);
        conv_matrix(C, (const float*)args.in[5], DM, FF, WGU, 128, 256, 128);
        conv_matrix(C, (const float*)args.in[6], FF, DM, WD, DM, 0, 0, true);
        conv_matrix(C, (const float*)args.in[8], DM, IND, WIN, IND, 0, 0);
        conv_matrix(C, (const float*)args.in[12], 1024, DM, WUA, DM, 0, 0);
        conv_matrix(C, (const float*)args.in[13], 1024, DM, WUB, DM, 0, 0);
        conv_matrix(C, (const float*)args.in[14], DM, DM, WOUT, DM, 0, 0);
        conv_matrix(C, (const float*)args.in[20], DM, DM, WPG, DM, 0, 0);
        conv_matrix(C, (const float*)args.in[21], PLE, DM, WPP, DM, 0, 0);
        rope_tables(C, (const int*)args.in[2], P_ROPEC, P_ROPES);
        norm_rows_bf16(C, PX, (const float*)args.in[3], H);
    }
    SEAM(0);
    int gbid = C.bid;
    {
        if (C.tid == 0) { unsigned* bar = (unsigned*)(ws + WS_BAR); bool ok = (C.G % 8) == 0;
            for (unsigned j = 0; j < 16; ++j) { const unsigned c = xb_ld(&bar[XB_XCNT(j)]); ok = ok && (c == (j < 8 ? (unsigned)C.G / 8u : 0u)); }
            xst[3] = ok ? (xst[2] * 8u + xbar.x) : (unsigned)C.bid; }
        __syncthreads();
        gbid = (int)xst[3];
    }
    if (IN(1)) { pg8::Gemm g{H, WGU, T, 2 * FF, DM}; S.init(T, 2 * FF, C.G, gbid); EpiSwiGLU E{ACT, nullptr}; pg8::gemm_phase(C.lds, g, S, E); }
    SEAM(1);
    if (IN(2)) { pg8::Gemm g{ACT, WD, T, DM, FF}; S.init(T, DM, C.G, gbid); EpiResidNorm E{PX, POUT, 0.5f, (const float*)args.in[7], H, SSQ0}; pg8::gemm_phase<EpiResidNorm, true, true>(C.lds, g, S, E); }
    SEAM(2);
    if (IN(3)) { pg8::Gemm g{H, WIN, T, IND, DM}; S.init(T, IND, C.G, gbid);
        EpiProj E{Qb, Kb, Vb, QB, IB, OG, GA, GB, LOGF, P_ROPEC, P_ROPES, (const float*)args.in[10], SSQ0}; pg8::gemm_phase(C.lds, g, S, E); }
    SEAM(3);
    if (IN(4)) { attn_phase(C, Qb, Kb, Vb, (const float*)args.in[9], OUTA); hgrn_pass1(C, LOGF, IB, STATE, DECAY); }
    SEAM(4);
    if (IN(5)) { hgrn_pass2(C, STATE, DECAY); __syncthreads();
        pg8::Gemm g{OUTA, WUA, T, DM, 1024}; S.init(T, DM, C.G, gbid); EpiBf<1> E{GA, nullptr}; pg8::gemm_phase(C.lds, g, S, E); }
    SEAM(5);
    if (IN(6)) hgrn_pass3(C, LOGF, QB, IB, OG, STATE, (const float*)args.in[11], OUTB);
    SEAM(6);
    if (IN(7)) {
        conv_matrix(C, (const float*)args.in[16], DM, FF, WGU, 128, 256, 0);
        conv_matrix(C, (const float*)args.in[17], DM, FF, WGU, 128, 256, 128);
        conv_matrix(C, (const float*)args.in[18], FF, DM, WD, DM, 0, 0, true);
        conv_p(C, (const float*)args.in[1], PBF); __syncthreads();
        pg8::Gemm g{OUTB, WUB, T, DM, 1024}; S.init(T, DM, C.G, gbid); EpiBf<2> E{GB, GA}; pg8::gemm_phase(C.lds, g, S, E); }
    SEAM(7);
    if (IN(8)) { pg8::Gemm g{GB, WOUT, T, DM, DM}; S.init(T, DM, C.G, gbid); EpiResidNorm E{POUT, POUT, 1.0f, (const float*)args.in[15], H, SSQ0 + T}; pg8::gemm_phase(C.lds, g, S, E); }
    SEAM(8);
    if (IN(9)) { { pg8::Gemm g{PBF, WPP, T, DM, PLE}; S.init(T, DM, C.G, gbid); EpiBf<0> E{PP, nullptr}; pg8::gemm_phase(C.lds, g, S, E); }
        pg8::Gemm g{H, WGU, T, 2 * FF, DM}; S.init(T, 2 * FF, C.G, gbid); EpiSwiGLU E{ACT, SSQ0 + T}; pg8::gemm_phase(C.lds, g, S, E); }
    SEAM(9);
    if (IN(10)) { pg8::Gemm g{ACT, WD, T, DM, FF}; S.init(T, DM, C.G, gbid); EpiResidNorm E{POUT, POUT, 0.5f, (const float*)args.in[19], H, SSQ0 + 2 * T}; pg8::gemm_phase<EpiResidNorm, true, true>(C.lds, g, S, E); }
    SEAM(10);
    if (IN(11)) { pg8::Gemm g{H, WPG, T, DM, DM}; S.init(T, DM, C.G, gbid, 4);
        EpiPleFinal E{POUT, POUT, PP, SSQ0 + 2 * T, SSQ0 + 3 * T, (unsigned*)(ws + WS_BAR) + 3584, (const float*)args.in[22]}; pg8::gemm_phase(C.lds, g, S, E); }
#undef IN
#undef SEAM
}

#ifndef PH_RUN
#define PH_RUN 0xffff
#endif
#ifndef DUP_MASK
#define DUP_MASK 0x0
#endif
#ifndef MK_PER_PHASE
#define MK_PER_PHASE 0
#endif
extern "C" void kernel_launch(void* const* d_in, const int* in_sizes, int n_in, void* d_out, int out_size, void* d_ws, size_t ws_size, hipStream_t stream) {
    static int grid = 0;
    if (grid == 0) {
        if (n_in != 23 || out_size != T * DM || ws_size < WS_END) { fprintf(stderr, "kernel_launch: unexpected problem (n_in %d, out %d, ws %zu)\n", n_in, out_size, ws_size); grid = -1; return; }
        int dev = 0, cus = 0, per_cu = 0;
        (void)hipGetDevice(&dev); (void)hipDeviceGetAttribute(&cus, hipDeviceAttributeMultiprocessorCount, dev);
        if (hipFuncSetAttribute((const void*)mega_fwd, hipFuncAttributeMaxDynamicSharedMemorySize, LDS_BYTES) != hipSuccess) { fprintf(stderr, "kernel_launch: hipFuncSetAttribute failed\n"); grid = -1; return; }
        if (hipOccupancyMaxActiveBlocksPerMultiprocessor(&per_cu, (const void*)mega_fwd, NTHREADS, LDS_BYTES) != hipSuccess || per_cu < 1) per_cu = 1;
        (void)hipGetLastError();
        grid = cus > 0 ? cus : 256;
    }
    if (grid < 0) return;
    Args a{};
    for (int i = 0; i < 23; ++i) a.in[i] = d_in[i];
    a.out = (float*)d_out; a.ws = (unsigned char*)d_ws;
#if MK_PER_PHASE
    for (int ph = 0; ph < 13; ++ph) { if (!((PH_RUN >> ph) & 1)) continue; a.ph_lo = ph; a.ph_hi = ph + 1; for (int rep = 0; rep < (((DUP_MASK >> ph) & 1) ? 2 : 1); ++rep) hipLaunchKernelGGL(mega_fwd, dim3(grid), dim3(NTHREADS), LDS_BYTES, stream, a); }
#else
    a.ph_lo = 0; a.ph_hi = 12;
    void* kargs[] = {&a};
    hipError_t e = hipLaunchCooperativeKernel((const void*)mega_fwd, dim3(grid), dim3(NTHREADS), kargs, LDS_BYTES, stream);
    if (e != hipSuccess) fprintf(stderr, "cooperative launch failed: %s (grid %d)\n", hipGetErrorString(e), grid);
#endif
}
```

```cpp
#include <hip/hip_runtime.h>
#include <hip/hip_cooperative_groups.h>
#include <cstdio>
#include <cstdint>
namespace cg = cooperative_groups;

#define LAS __attribute__((address_space(3)))
typedef unsigned short bf16_t;
typedef short bf16x8 __attribute__((ext_vector_type(8)));
typedef float f32x4 __attribute__((ext_vector_type(4)));
typedef unsigned u32x4 __attribute__((ext_vector_type(4)));
typedef unsigned u32x2 __attribute__((ext_vector_type(2)));

constexpr int NBATCH = 4, SEQ = 4096, T = NBATCH * SEQ, DM = 2048, FF = 5632, IND = 9728, PLE = 256;
constexpr float EPS = 1e-6f;
constexpr float LOG2E = 1.4426950408889634f;
constexpr float QSCALE = 0.125f * LOG2E;
constexpr int NWAVES = 8, NTHREADS = NWAVES * 64;
constexpr int LDS_BYTES = 147456;

constexpr size_t MiB = 1u << 20;
constexpr size_t WS_ROPE = 0;
constexpr size_t WS_WA_GU = 1 * MiB, WS_WA_D = 45 * MiB;
constexpr size_t WS_STATE = 1 * MiB;
constexpr size_t WS_WIN = 67 * MiB;
constexpr size_t WS_PBF = 67 * MiB, WS_DECAY = 75 * MiB;
constexpr size_t WS_WUA = 105 * MiB, WS_WUB = 109 * MiB, WS_WOUT = 113 * MiB, WS_WPG = 121 * MiB, WS_WPP = 129 * MiB;
constexpr size_t WS_H = 130 * MiB;
constexpr size_t WS_OUTA = 130 * MiB, WS_OUTB = 162 * MiB;
constexpr size_t WS_ACT = 194 * MiB;
constexpr size_t WS_Q = 194 * MiB, WS_K = 226 * MiB, WS_V = 234 * MiB, WS_QB = 242 * MiB, WS_IB = 274 * MiB, WS_OG = 306 * MiB;
constexpr size_t WS_GA = 338 * MiB, WS_GB = 402 * MiB, WS_LOGF = 466 * MiB;
constexpr size_t WS_PP = 402 * MiB;
constexpr size_t WS_SS = 530 * MiB;
constexpr size_t WS_BAR = 530 * MiB + 512 * 1024;
constexpr size_t WS_END = 531 * MiB;

typedef float f32x2_t __attribute__((ext_vector_type(2))); typedef __bf16 bf16x2_t __attribute__((ext_vector_type(2)));
__device__ __forceinline__ unsigned cvt_pk_bf16(float lo, float hi) { const f32x2_t v = {lo, hi}; const bf16x2_t b = __builtin_convertvector(v, bf16x2_t); return __builtin_bit_cast(unsigned, b); }
__device__ __forceinline__ bf16_t f2bf(float f) { return (bf16_t)(cvt_pk_bf16(f, 0.f) & 0xffffu); }
__device__ __forceinline__ float bf2f(unsigned b) { return __uint_as_float(b << 16); }
__device__ __forceinline__ float bflo(unsigned w) { return __uint_as_float(w << 16); }
__device__ __forceinline__ float bfhi(unsigned w) { return __uint_as_float(w & 0xffff0000u); }
__device__ __forceinline__ float ex2(float x) { return __builtin_amdgcn_exp2f(x); }
__device__ __forceinline__ float rcpf_(float x) { return __builtin_amdgcn_rcpf(x); }
__device__ __forceinline__ float sigm(float x) { return rcpf_(1.f + ex2(-LOG2E * x)); }
__device__ __forceinline__ float silu(float x) { return x * sigm(x); }
__device__ __forceinline__ float wave_sum(float v) {
#pragma unroll
    for (int o = 1; o < 64; o <<= 1) v += __shfl_xor(v, o);
    return v;
}
template <int CTRL> __device__ __forceinline__ float dppmov(float v) { return __int_as_float(__builtin_amdgcn_update_dpp(0, __float_as_int(v), CTRL, 0xF, 0xF, true)); }
__device__ __forceinline__ float grp16_sum(float v) { v += dppmov<0xB1>(v); v += dppmov<0x4E>(v); v += dppmov<0x124>(v); v += dppmov<0x128>(v); return v; }
__device__ __forceinline__ float grp16_max(float v) { v = fmaxf(v, dppmov<0xB1>(v)); v = fmaxf(v, dppmov<0x4E>(v)); v = fmaxf(v, dppmov<0x124>(v)); v = fmaxf(v, dppmov<0x128>(v)); return v; }
#define MFMA16(a, b, c) __builtin_amdgcn_mfma_f32_16x16x32_bf16((a), (b), (c), 0, 0, 0)

namespace pg8 {
constexpr int BM = 256, BK = 64, HALF = 128, HTB = HALF * BK * 2, STAGE_BYTES = 8 * HTB, NXCD = 8, WGM = 8;
__device__ __forceinline__ int lds_byte(int r, int c) { const int st = (r >> 4) * 2 + (c >> 5), rr = r & 15, cc = c & 31, ob = rr * 64 + cc * 2; return st * 1024 + (ob ^ (((ob >> 9) & 1) << 5)); }
__device__ __forceinline__ void stage_rc(int b, int& R, int& C) { const int st = b / 1024, sb = b % 1024, swz = sb ^ (((sb >> 9) & 1) << 5); R = (st >> 1) * 16 + swz / 64; C = (st & 1) * 32 + (swz % 64) / 2; }
__device__ __forceinline__ int perm32(int rho) { const int n = rho >> 4, i = rho & 15; return 8 * (i >> 2) + 4 * n + (i & 3); }
struct Unit { int pm, pn; };
struct Gemm { const bf16_t* A; const bf16_t* Bt; int M, N, K; };
struct StaticOrder {
    int nM, nN, nwg, G, c, wgm;
    __device__ void init(int M, int N, int G_, int c_, int wgm_ = 8) { nM = M / BM; nN = N / BM; nwg = nM * nN; G = G_; c = c_; wgm = wgm_; }
    __device__ bool next(int i, Unit& u) const {
        const long L = (long)i * G + c; if (L >= nwg) return false;
        int wgid = (int)L; { const int q = nwg / NXCD, r = nwg % NXCD, xcd = wgid % NXCD, off = wgid / NXCD; wgid = (xcd < r ? xcd * (q + 1) : r * (q + 1) + (xcd - r) * q) + off; }
        const int nig = wgm * nN, gid = wgid / nig, fm = gid * wgm, gsz = (nM - fm) < wgm ? (nM - fm) : wgm;
        u.pm = fm + ((wgid % nig) % gsz); u.pn = (wgid % nig) / gsz; return true;
    }
};

#ifndef PG8_SP2
#define PG8_SP2 true
#endif
template <class Epi, bool AT = false, bool BT = false, bool SP2 = PG8_SP2>
__device__ __forceinline__ void gemm_phase(LAS unsigned char* lds, const Gemm g, const StaticOrder& S, const Epi& E) {
    const int tid = threadIdx.x, wid = __builtin_amdgcn_readfirstlane(tid >> 6), lane = tid & 63, wr = wid >> 2, wc = wid & 3, fr = lane & 15, fq = lane >> 4;
    int K = g.K; asm volatile("" : "+s"(K));
    const int nt = K / BK;
    unsigned voffA[2], voffB[2];
#pragma unroll
    for (int i = 0; i < 2; ++i) { int R, C; stage_rc(tid * 16 + i * 8192, R, C); const int Rb = Epi::PERM ? ((R & ~31) + perm32(R & 31)) : R;
        voffA[i] = (unsigned)(R * (AT ? 64 : K) + C) * 2u; voffB[i] = (unsigned)(Rb * (BT ? 64 : K) + C) * 2u; }
    const size_t tstep = (size_t)BM * K * 2;
    const size_t kstepA = AT ? (size_t)BM * BK * 2 : (size_t)(BK * 2), kstepB = BT ? (size_t)BM * BK * 2 : (size_t)(BK * 2);
    const size_t hstepA = AT ? (size_t)HALF * BK * 2 : (size_t)HALF * K * 2, hstepB = BT ? (size_t)HALF * BK * 2 : (size_t)HALF * K * 2;
    const unsigned ldsw = (unsigned)wid * 1024u;
    const int aoff = lds_byte(wr * 64 + fr, fq * 8), boff = lds_byte(wc * 32 + fr, fq * 8);
#define PG8_SA(b, h) (((b) * 2 + (h)) * HTB)
#define PG8_SB(b, h) ((4 + (b) * 2 + (h)) * HTB)
#define PG8_STAGE(bufoff, gbase, voff) do { _Pragma("unroll") for (int _i = 0; _i < 2; ++_i) \
        __builtin_amdgcn_global_load_lds((const unsigned*)((const char*)(gbase) + (voff)[_i]), (LAS unsigned*)(lds + (bufoff) + ldsw + _i * 8192), 16, 0, 0); } while (0)
#define PG8_LDA(dst, b, h) do { _Pragma("unroll") for (int m = 0; m < 4; ++m) _Pragma("unroll") for (int k = 0; k < 2; ++k) dst[m][k] = *(const LAS bf16x8*)(lds + PG8_SA(b, h) + aoff + m * 2048 + k * 1024); } while (0)
#define PG8_LDB(dst, b, h) do { _Pragma("unroll") for (int n = 0; n < 2; ++n) _Pragma("unroll") for (int k = 0; k < 2; ++k) dst[n][k] = *(const LAS bf16x8*)(lds + PG8_SB(b, h) + boff + n * 2048 + k * 1024); } while (0)
#define PG8_MMA(ai, bj, At, Bt) do { __builtin_amdgcn_s_setprio(1); _Pragma("unroll") for (int m = 0; m < 4; ++m) _Pragma("unroll") for (int n = 0; n < 2; ++n) _Pragma("unroll") for (int k = 0; k < 2; ++k) \
        acc[ai][bj][m][n] = __builtin_amdgcn_mfma_f32_16x16x32_bf16(Bt[n][k], At[m][k], acc[ai][bj][m][n], 0, 0, 0); __builtin_amdgcn_s_setprio(0); } while (0)
#define PG8_WAIT_V(n) asm volatile("s_waitcnt vmcnt(" #n ")" ::: "memory")
#define PG8_WAIT_L(n) asm volatile("s_waitcnt lgkmcnt(" #n ")" ::: "memory")
#define PG8_BAR __builtin_amdgcn_s_barrier()
#define PG8_SCHED __builtin_amdgcn_sched_barrier(0)
    Unit cur, nxt; int ui = 0;
    if (!S.next(0, cur)) return;
    f32x4 acc[2][2][4][2];
#pragma unroll
    for (int a = 0; a < 2; ++a)
#pragma unroll
        for (int b = 0; b < 2; ++b)
#pragma unroll
            for (int m = 0; m < 4; ++m)
#pragma unroll
                for (int n = 0; n < 2; ++n) acc[a][b][m][n] = (f32x4){0.f, 0.f, 0.f, 0.f};
    bf16x8 At[4][2], B0[2][2], B1[2][2];
    const char* cA = (const char*)g.A + (size_t)cur.pm * tstep; const char* cB = (const char*)g.Bt + (size_t)cur.pn * tstep;
    if (SP2) { PG8_STAGE(PG8_SB(0, 0), cB, voffB); PG8_STAGE(PG8_SB(0, 1), cB + hstepB, voffB); PG8_STAGE(PG8_SA(0, 0), cA, voffA); PG8_STAGE(PG8_SA(0, 1), cA + hstepA, voffA); }
    else { PG8_STAGE(PG8_SB(0, 0), cB, voffB); PG8_STAGE(PG8_SA(0, 0), cA, voffA); PG8_STAGE(PG8_SB(0, 1), cB + hstepB, voffB); PG8_STAGE(PG8_SA(0, 1), cA + hstepA, voffA); }
    if (wr == 1) PG8_BAR;
    if (SP2) PG8_WAIT_V(2); else PG8_WAIT_V(4);
    PG8_BAR;
    PG8_STAGE(PG8_SB(1, 0), cB + kstepB, voffB); PG8_STAGE(PG8_SA(1, 0), cA + kstepA, voffA); PG8_STAGE(PG8_SB(1, 1), cB + hstepB + kstepB, voffB);
    PG8_WAIT_V(6); PG8_BAR;
    for (;;) {
        const bool has_next = S.next(ui + 1, nxt);
        const char* nA = has_next ? (const char*)g.A + (size_t)nxt.pm * tstep : cA; const char* nB = has_next ? (const char*)g.Bt + (size_t)nxt.pn * tstep : cB;
        for (int t = 0; t < nt; t += 2) {
            const bool last = (t == nt - 2);
            const char* a1 = cA + (size_t)(t + 1) * kstepA;
            const char* a2 = last ? nA : cA + (size_t)(t + 2) * kstepA; const char* b2 = last ? nB : cB + (size_t)(t + 2) * kstepB;
            const char* a3 = a2 + kstepA; const char* b3 = b2 + kstepB;
            if constexpr (SP2) {
            PG8_LDB(B0, 0, 0); PG8_LDB(B1, 0, 1); PG8_SCHED; PG8_LDA(At, 0, 0); PG8_STAGE(PG8_SA(1, 1), a1 + hstepA, voffA);
            PG8_WAIT_V(8); PG8_WAIT_L(0); PG8_BAR; PG8_MMA(0, 0, At, B0); PG8_MMA(0, 1, At, B1); PG8_BAR; PG8_SCHED;
            PG8_LDA(At, 0, 1); PG8_STAGE(PG8_SB(0, 0), b2, voffB); PG8_STAGE(PG8_SB(0, 1), b2 + hstepB, voffB); PG8_STAGE(PG8_SA(0, 0), a2, voffA);
            PG8_WAIT_V(8); PG8_WAIT_L(0); PG8_BAR; PG8_MMA(1, 0, At, B0); PG8_MMA(1, 1, At, B1); PG8_BAR; PG8_SCHED;
            PG8_LDB(B0, 1, 0); PG8_LDB(B1, 1, 1); PG8_SCHED; PG8_LDA(At, 1, 0); PG8_STAGE(PG8_SA(0, 1), a2 + hstepA, voffA);
            PG8_WAIT_V(8); PG8_WAIT_L(0); PG8_BAR; PG8_MMA(0, 0, At, B0); PG8_MMA(0, 1, At, B1); PG8_BAR; PG8_SCHED;
            PG8_LDA(At, 1, 1); PG8_STAGE(PG8_SB(1, 0), b3, voffB); PG8_STAGE(PG8_SB(1, 1), b3 + hstepB, voffB); PG8_STAGE(PG8_SA(1, 0), a3, voffA);
            PG8_WAIT_V(8); PG8_WAIT_L(0); PG8_BAR; PG8_MMA(1, 0, At, B0); PG8_MMA(1, 1, At, B1); PG8_BAR; PG8_SCHED;
            } else {
            PG8_LDB(B0, 0, 0); PG8_SCHED; PG8_LDA(At, 0, 0); PG8_STAGE(PG8_SA(1, 1), a1 + hstepA, voffA);
            PG8_WAIT_L(8); PG8_BAR; PG8_WAIT_L(0); PG8_MMA(0, 0, At, B0); PG8_BAR; PG8_SCHED;
            PG8_LDB(B1, 0, 1); PG8_STAGE(PG8_SB(0, 0), b2, voffB);
            PG8_BAR; PG8_WAIT_L(0); PG8_MMA(0, 1, At, B1); PG8_BAR;
            PG8_LDA(At, 0, 1); PG8_STAGE(PG8_SA(0, 0), a2, voffA);
            PG8_BAR; PG8_WAIT_L(0); PG8_MMA(1, 0, At, B0); PG8_BAR; PG8_SCHED;
            PG8_STAGE(PG8_SB(0, 1), b2 + hstepB, voffB);
            PG8_WAIT_V(6); PG8_BAR; PG8_MMA(1, 1, At, B1); PG8_BAR;
            PG8_LDB(B0, 1, 0); PG8_SCHED; PG8_LDA(At, 1, 0); PG8_STAGE(PG8_SA(0, 1), a2 + hstepA, voffA);
            PG8_WAIT_L(8); PG8_BAR; PG8_WAIT_L(0); PG8_MMA(0, 0, At, B0); PG8_BAR; PG8_SCHED;
            PG8_LDB(B1, 1, 1); PG8_STAGE(PG8_SB(1, 0), b3, voffB);
            PG8_BAR; PG8_WAIT_L(0); PG8_MMA(0, 1, At, B1); PG8_BAR;
            PG8_LDA(At, 1, 1); PG8_STAGE(PG8_SA(1, 0), a3, voffA);
            PG8_BAR; PG8_WAIT_L(0); PG8_MMA(1, 0, At, B0); PG8_BAR; PG8_SCHED;
            PG8_STAGE(PG8_SB(1, 1), b3 + hstepB, voffB);
            PG8_WAIT_V(6); PG8_BAR; PG8_MMA(1, 1, At, B1); PG8_BAR;
            }
        }
        if (wr == 0) PG8_BAR;
        E(acc, cur, wr, wc, fr, fq);
        if (!has_next) break;
#pragma unroll
        for (int a = 0; a < 2; ++a)
#pragma unroll
            for (int b = 0; b < 2; ++b)
#pragma unroll
                for (int m = 0; m < 4; ++m)
#pragma unroll
                    for (int n = 0; n < 2; ++n) acc[a][b][m][n] = (f32x4){0.f, 0.f, 0.f, 0.f};
        cur = nxt; cA = nA; cB = nB; ++ui;
        if (wr == 1) PG8_BAR;
    }
    PG8_WAIT_V(0);
    PG8_BAR;
#undef PG8_SA
#undef PG8_SB
#undef PG8_STAGE
#undef PG8_LDA
#undef PG8_LDB
#undef PG8_MMA
#undef PG8_WAIT_V
#undef PG8_WAIT_L
#undef PG8_BAR
#undef PG8_SCHED
}
}
using pg8::Unit;

__device__ __forceinline__ u32x4 pack8(const f32x4 a, const f32x4 b) { u32x4 w; w.x = cvt_pk_bf16(a[0], a[1]); w.y = cvt_pk_bf16(a[2], a[3]); w.z = cvt_pk_bf16(b[0], b[1]); w.w = cvt_pk_bf16(b[2], b[3]); return w; }
__device__ __forceinline__ void unpack8(const u32x4 w, f32x4& a, f32x4& b) { a = (f32x4){bflo(w.x), bfhi(w.x), bflo(w.y), bfhi(w.y)}; b = (f32x4){bflo(w.z), bfhi(w.z), bflo(w.w), bfhi(w.w)}; }

struct EpiSwiGLU {
    static constexpr bool PERM = true;
    bf16_t* O; const float* ss;
    __device__ __forceinline__ void operator()(const f32x4 (&acc)[2][2][4][2], const Unit& u, int wr, int wc, int fr, int fq) const {
        const int rl0 = wr * 64 + fr, kt = u.pn * 2 + (wc >> 1), within = (wc & 1) * 32 + 8 * fq;
        float rsv[2][4];
#pragma unroll
        for (int ai = 0; ai < 2; ++ai)
#pragma unroll
            for (int m = 0; m < 4; ++m) rsv[ai][m] = ss ? ss[u.pm * 256 + rl0 + ai * 128 + m * 16] : 0.f;
#pragma unroll
        for (int ai = 0; ai < 2; ++ai)
#pragma unroll
            for (int m = 0; m < 4; ++m) {
                const float rs = ss ? 1.0f / sqrtf(rsv[ai][m] * (1.f / DM) + EPS) : 1.f;
                f32x4 v0, v1;
#pragma unroll
                for (int j = 0; j < 4; ++j) { v0[j] = silu(acc[ai][0][m][0][j] * rs) * (acc[ai][1][m][0][j] * rs); v1[j] = silu(acc[ai][0][m][1][j] * rs) * (acc[ai][1][m][1][j] * rs); }
                *(u32x4*)(O + ((size_t)u.pm * (FF / 64) + kt) * 16384 + (size_t)(rl0 + ai * 128 + m * 16) * 64 + within) = pack8(v0, v1);
            }
    }
};
struct EpiResid {
    static constexpr bool PERM = false;
    const float* base; float* out; float scale;
    __device__ __forceinline__ void operator()(const f32x4 (&acc)[2][2][4][2], const Unit& u, int wr, int wc, int fr, int fq) const {
        const int row0 = u.pm * 256 + wr * 64 + fr, col0 = u.pn * 256 + wc * 32 + 4 * fq;
#pragma unroll
        for (int ai = 0; ai < 2; ++ai)
#pragma unroll
            for (int m = 0; m < 4; ++m) { const size_t off = (size_t)(row0 + ai * 128 + m * 16) * DM + col0;
#pragma unroll
                for (int bj = 0; bj < 2; ++bj)
#pragma unroll
                    for (int n = 0; n < 2; ++n) { const f32x4 b = *(const f32x4*)(base + off + bj * 128 + n * 16); *(f32x4*)(out + off + bj * 128 + n * 16) = b + scale * acc[ai][bj][m][n]; }
                asm volatile("" ::: "memory"); }
    }
};
struct EpiResidNorm {
    static constexpr bool PERM = false;
    const float* base; float* out; float scale; const float* nw; bf16_t* hb; float* ss;
    __device__ __forceinline__ void operator()(const f32x4 (&acc)[2][2][4][2], const Unit& u, int wr, int wc, int fr, int fq) const {
        const int row0 = u.pm * 256 + wr * 64 + fr, col0 = u.pn * 256 + wc * 32 + 4 * fq;
        f32x4 wv[2][2];
#pragma unroll
        for (int bj = 0; bj < 2; ++bj)
#pragma unroll
            for (int n = 0; n < 2; ++n) wv[bj][n] = *(const f32x4*)(nw + col0 + bj * 128 + n * 16);
        f32x4 pre[3][2][2];
#define ERN_LOAD(g, slot) do { _Pragma("unroll") for (int bj = 0; bj < 2; ++bj) _Pragma("unroll") for (int n = 0; n < 2; ++n) \
        pre[slot][bj][n] = *(const f32x4*)(base + (size_t)(row0 + ((g) >> 2) * 128 + ((g) & 3) * 16) * DM + col0 + bj * 128 + n * 16); } while (0)
        ERN_LOAD(0, 0); ERN_LOAD(1, 1);
#pragma unroll
        for (int g = 0; g < 8; ++g) { const int ai = g >> 2, m = g & 3, slot = g % 3;
            if (g < 6) { if ((g + 2) % 3 == 0) ERN_LOAD(g + 2, 0); else if ((g + 2) % 3 == 1) ERN_LOAD(g + 2, 1); else ERN_LOAD(g + 2, 2); }
            { const int row = row0 + ai * 128 + m * 16; const size_t off = (size_t)row * DM + col0; float s = 0.f;
#pragma unroll
                for (int bj = 0; bj < 2; ++bj)
#pragma unroll
                    for (int n = 0; n < 2; ++n) { const size_t o = off + bj * 128 + n * 16; const f32x4 r = pre[slot][bj][n] + scale * acc[ai][bj][m][n]; *(f32x4*)(out + o) = r;
                        s += (r[0] * r[0] + r[1] * r[1]) + (r[2] * r[2] + r[3] * r[3]); const f32x4 hv = r * wv[bj][n];
                        u32x2 hw; hw.x = cvt_pk_bf16(hv[0], hv[1]); hw.y = cvt_pk_bf16(hv[2], hv[3]); *(u32x2*)(hb + o) = hw; }
                s += __shfl_xor(s, 16); s += __shfl_xor(s, 32);
                if (fq == 0) __hip_atomic_fetch_add(ss + row, s, __ATOMIC_RELAXED, __HIP_MEMORY_SCOPE_AGENT); }
            asm volatile("" ::: "memory"); }
#undef ERN_LOAD
    }
};
struct EpiPle {
    static constexpr bool PERM = false;
    const float* base; float* out; const bf16_t* pp; const float* ss;
    __device__ __forceinline__ void operator()(const f32x4 (&acc)[2][2][4][2], const Unit& u, int wr, int wc, int fr, int fq) const {
        const int row0 = u.pm * 256 + wr * 64 + fr, col0 = u.pn * 256 + wc * 32 + 4 * fq;
        float rsv[2][4];
#pragma unroll
        for (int ai = 0; ai < 2; ++ai)
#pragma unroll
            for (int m = 0; m < 4; ++m) rsv[ai][m] = ss[row0 + ai * 128 + m * 16];
        f32x4 pb[2][2][2]; u32x2 pw[2][2][2];
#define EPL_LOAD(g, slot) do { _Pragma("unroll") for (int bj = 0; bj < 2; ++bj) _Pragma("unroll") for (int n = 0; n < 2; ++n) { \
        const size_t o_ = (size_t)(row0 + ((g) >> 2) * 128 + ((g) & 3) * 16) * DM + col0 + bj * 128 + n * 16; pb[slot][bj][n] = *(const f32x4*)(base + o_); pw[slot][bj][n] = *(const u32x2*)(pp + o_); } } while (0)
        EPL_LOAD(0, 0);
#pragma unroll
        for (int g = 0; g < 8; ++g) { const int ai = g >> 2, m = g & 3, slot = g & 1;
            if (g < 7) { if (slot == 0) EPL_LOAD(g + 1, 1); else EPL_LOAD(g + 1, 0); }
            const float rs = 1.0f / sqrtf(rsv[ai][m] * (1.f / DM) + EPS);
#pragma unroll
            for (int bj = 0; bj < 2; ++bj)
#pragma unroll
                for (int n = 0; n < 2; ++n) { const size_t o = (size_t)(row0 + ai * 128 + m * 16) * DM + col0 + bj * 128 + n * 16; const u32x2 w2 = pw[slot][bj][n];
                    const f32x4 pv = (f32x4){bflo(w2.x), bfhi(w2.x), bflo(w2.y), bfhi(w2.y)}; f32x4 r;
#pragma unroll
                    for (int j = 0; j < 4; ++j) r[j] = pb[slot][bj][n][j] + sigm(acc[ai][bj][m][n][j] * rs) * pv[j];
                    *(f32x4*)(out + o) = r; }
            asm volatile("" ::: "memory"); }
#undef EPL_LOAD
    }
};
struct EpiPleFinal {
    static constexpr bool PERM = false;
    const float* base; float* out; const bf16_t* pp; const float* ss; float* ss3; unsigned* cnt; const float* fw;
    __device__ __forceinline__ void operator()(f32x4 (&acc)[2][2][4][2], const Unit& u, int wr, int wc, int fr, int fq) const {
        const int row0 = u.pm * 256 + wr * 64 + fr, col0 = u.pn * 256 + wc * 32 + 4 * fq;
        float rsv[2][4];
#pragma unroll
        for (int ai = 0; ai < 2; ++ai)
#pragma unroll
            for (int m = 0; m < 4; ++m) rsv[ai][m] = ss[row0 + ai * 128 + m * 16];
        f32x4 pb[2][2][2]; u32x2 pw[2][2][2];
#define EPF_LOAD(g, slot) do { _Pragma("unroll") for (int bj = 0; bj < 2; ++bj) _Pragma("unroll") for (int n = 0; n < 2; ++n) { \
        const size_t o_ = (size_t)(row0 + ((g) >> 2) * 128 + ((g) & 3) * 16) * DM + col0 + bj * 128 + n * 16; pb[slot][bj][n] = *(const f32x4*)(base + o_); pw[slot][bj][n] = *(const u32x2*)(pp + o_); } } while (0)
        EPF_LOAD(0, 0);
#pragma unroll
        for (int g = 0; g < 8; ++g) { const int ai = g >> 2, m = g & 3, slot = g & 1;
            if (g < 7) { if (slot == 0) EPF_LOAD(g + 1, 1); else EPF_LOAD(g + 1, 0); }
            const float rs = 1.0f / sqrtf(rsv[ai][m] * (1.f / DM) + EPS); float s = 0.f;
#pragma unroll
            for (int bj = 0; bj < 2; ++bj)
#pragma unroll
                for (int n = 0; n < 2; ++n) { const u32x2 w2 = pw[slot][bj][n]; const f32x4 pv = (f32x4){bflo(w2.x), bfhi(w2.x), bflo(w2.y), bfhi(w2.y)}; f32x4 r;
#pragma unroll
                    for (int j = 0; j < 4; ++j) r[j] = pb[slot][bj][n][j] + sigm(acc[ai][bj][m][n][j] * rs) * pv[j];
                    acc[ai][bj][m][n] = r; s += (r[0] * r[0] + r[1] * r[1]) + (r[2] * r[2] + r[3] * r[3]); }
            s += __shfl_xor(s, 16); s += __shfl_xor(s, 32);
            if (fq == 0) __hip_atomic_fetch_add(ss3 + row0 + ai * 128 + m * 16, s, __ATOMIC_RELAXED, __HIP_MEMORY_SCOPE_AGENT); }
#undef EPF_LOAD
        asm volatile("s_waitcnt vmcnt(0) lgkmcnt(0)" ::: "memory"); __builtin_amdgcn_s_barrier(); asm volatile("" ::: "memory");
        if (threadIdx.x == 0) { unsigned* c = cnt + 8 * u.pm; (void)__hip_atomic_fetch_add(c, 1u, __ATOMIC_RELAXED, __HIP_MEMORY_SCOPE_AGENT); unsigned sp = 0u;
            while (__hip_atomic_load(c, __ATOMIC_RELAXED, __HIP_MEMORY_SCOPE_AGENT) < 8u && ++sp < 100000u) __builtin_amdgcn_s_sleep(2);
            __builtin_amdgcn_fence(__ATOMIC_ACQUIRE, "agent"); asm volatile("s_waitcnt vmcnt(0)" ::: "memory"); }
        __builtin_amdgcn_s_barrier(); asm volatile("" ::: "memory");
        f32x4 fwv[2][2];
#pragma unroll
        for (int bj = 0; bj < 2; ++bj)
#pragma unroll
            for (int n = 0; n < 2; ++n) fwv[bj][n] = *(const f32x4*)(fw + col0 + bj * 128 + n * 16);
        float tot[2][4];
#pragma unroll
        for (int ai = 0; ai < 2; ++ai)
#pragma unroll
            for (int m = 0; m < 4; ++m) tot[ai][m] = __hip_atomic_load(ss3 + row0 + ai * 128 + m * 16, __ATOMIC_RELAXED, __HIP_MEMORY_SCOPE_AGENT);
#pragma unroll
        for (int ai = 0; ai < 2; ++ai)
#pragma unroll
            for (int m = 0; m < 4; ++m) { const float rstd = 1.0f / sqrtf(tot[ai][m] * (1.f / DM) + EPS); const size_t off = (size_t)(row0 + ai * 128 + m * 16) * DM + col0;
#pragma unroll
                for (int bj = 0; bj < 2; ++bj)
#pragma unroll
                    for (int n = 0; n < 2; ++n) *(f32x4*)(out + off + bj * 128 + n * 16) = acc[ai][bj][m][n] * rstd * fwv[bj][n]; }
    }
};
template <int MODE> struct EpiBf {
    static constexpr bool PERM = true;
    bf16_t* O; const bf16_t* X;
    __device__ __forceinline__ void operator()(const f32x4 (&acc)[2][2][4][2], const Unit& u, int wr, int wc, int fr, int fq) const {
        const int row0 = u.pm * 256 + wr * 64 + fr, col0 = u.pn * 256 + wc * 32 + 8 * fq;
#pragma unroll
        for (int ai = 0; ai < 2; ++ai) {
            u32x4 po[4][2], px[4][2];
            if (MODE >= 1) {
#pragma unroll
                for (int m = 0; m < 4; ++m)
#pragma unroll
                    for (int bj = 0; bj < 2; ++bj) { const size_t o = (size_t)(row0 + ai * 128 + m * 16) * DM + col0 + bj * 128; po[m][bj] = *(const u32x4*)(O + o); if (MODE == 2) px[m][bj] = *(const u32x4*)(X + o); } }
#pragma unroll
            for (int m = 0; m < 4; ++m)
#pragma unroll
                for (int bj = 0; bj < 2; ++bj) { const size_t o = (size_t)(row0 + ai * 128 + m * 16) * DM + col0 + bj * 128;
                    f32x4 v0 = acc[ai][bj][m][0], v1 = acc[ai][bj][m][1];
                    if (MODE >= 1) { f32x4 g0, g1; unpack8(po[m][bj], g0, g1); v0 = v0 * g0; v1 = v1 * g1; }
                    if (MODE == 2) { f32x4 x0, x1; unpack8(px[m][bj], x0, x1); v0 = v0 + x0; v1 = v1 + x1; }
                    *(u32x4*)(O + o) = pack8(v0, v1); }
            asm volatile("" ::: "memory"); }
    }
};
struct EpiProj {
    static constexpr bool PERM = true;
    bf16_t *Q, *Kk, *V, *QB, *IB, *OG, *GA, *GB; float* LOGF; const float* ropec; const float* ropes; const float* lbp; const float* ss;
    __device__ __forceinline__ void operator()(const f32x4 (&acc)[2][2][4][2], const Unit& u, int wr, int wc, int fr, int fq) const {
        const int pn = u.pn, row0 = u.pm * 256 + wr * 64 + fr, cw = wc * 32 + 8 * fq;
        float rs[2][4];
#pragma unroll
        for (int ai = 0; ai < 2; ++ai)
#pragma unroll
            for (int m = 0; m < 4; ++m) rs[ai][m] = 1.0f / sqrtf(ss[row0 + ai * 128 + m * 16] * (1.f / DM) + EPS);
        if (pn < 5) {
            bf16_t* base = pn < 4 ? Q : Kk; const int ld = pn < 4 ? 1024 : 256, colt = pn < 4 ? pn * 256 : 0; const float sc = pn < 4 ? QSCALE : 1.f;
            const bool ropew = ((wc & 1) == 0) && (fq < 2);
#pragma unroll
            for (int ai = 0; ai < 2; ++ai)
#pragma unroll
              for (int mh = 0; mh < 2; ++mh) {
                f32x4 rc0[2], rc1[2], rs0[2], rs1[2];
#pragma unroll
                for (int ml = 0; ml < 2; ++ml) { const size_t rr = (size_t)(row0 + ai * 128 + (2 * mh + ml) * 16) * 8;
                    rc0[ml] = (f32x4){1.f, 1.f, 1.f, 1.f}; rc1[ml] = rc0[ml]; rs0[ml] = (f32x4){0.f, 0.f, 0.f, 0.f}; rs1[ml] = rs0[ml];
                    if (ropew) { rc0[ml] = *(const f32x4*)(ropec + rr); rc1[ml] = *(const f32x4*)(ropec + rr + 4); rs0[ml] = *(const f32x4*)(ropes + rr); rs1[ml] = *(const f32x4*)(ropes + rr + 4); } }
#pragma unroll
                for (int ml = 0; ml < 2; ++ml) { const int m = 2 * mh + ml; const int row = row0 + ai * 128 + m * 16;
                    f32x4 c0 = rc0[ml], c1 = rc1[ml], s0 = rs0[ml], s1 = rs1[ml];
                    if (ropew && fq == 0) { s0 = -s0; s1 = -s1; }
#pragma unroll
                    for (int bj = 0; bj < 2; ++bj) { f32x4 v0 = acc[ai][bj][m][0] * rs[ai][m], v1 = acc[ai][bj][m][1] * rs[ai][m], p0, p1;
#pragma unroll
                        for (int j = 0; j < 4; ++j) { p0[j] = __shfl_xor(v0[j], 16); p1[j] = __shfl_xor(v1[j], 16); }
                        v0 = (v0 * c0 + p0 * s0) * sc; v1 = (v1 * c1 + p1 * s1) * sc;
                        *(u32x4*)(base + (size_t)row * ld + colt + bj * 128 + cw) = pack8(v0, v1); } }
                asm volatile("" ::: "memory"); }
        } else if (pn >= 10 && pn < 14) {
            const int colt = (pn - 10) * 256;
            f32x4 lb[2][2];
#pragma unroll
            for (int bj = 0; bj < 2; ++bj)
#pragma unroll
                for (int n = 0; n < 2; ++n) { const int c = colt + bj * 128 + cw + 4 * n; const f32x4 a0 = *(const f32x4*)(lbp + c), a1 = *(const f32x4*)(lbp + 1024 + c);
#pragma unroll
                    for (int j = 0; j < 4; ++j) lb[bj][n][j] = rcpf_(1.f + ex2(LOG2E * (a1[j] - a0[j]))); }
#pragma unroll
            for (int ai = 0; ai < 2; ++ai)
#pragma unroll
                for (int m = 0; m < 4; ++m) { const int row = row0 + ai * 128 + m * 16;
#pragma unroll
                    for (int bj = 0; bj < 2; ++bj)
#pragma unroll
                        for (int n = 0; n < 2; ++n) { f32x4 r;
#pragma unroll
                            for (int j = 0; j < 4; ++j) { const float l = lb[bj][n][j]; r[j] = __builtin_amdgcn_logf(l + (1.f - l) * sigm(acc[ai][bj][m][n][j] * rs[ai][m])); }
                            *(f32x4*)(LOGF + (size_t)row * 1024 + colt + bj * 128 + cw + 4 * n) = r; }
                    asm volatile("" ::: "memory"); }
        } else {
            bf16_t* base; int ld, colt, act;
            if (pn == 5) { base = V; ld = 256; colt = 0; act = 0; }
            else if (pn < 10) { base = QB; ld = 1024; colt = (pn - 6) * 256; act = 1; }
            else if (pn < 18) { base = IB; ld = 1024; colt = (pn - 14) * 256; act = 0; }
            else if (pn < 22) { base = OG; ld = 1024; colt = (pn - 18) * 256; act = 1; }
            else if (pn < 30) { base = GA; ld = 2048; colt = (pn - 22) * 256; act = 2; }
            else { base = GB; ld = 2048; colt = (pn - 30) * 256; act = 2; }
#pragma unroll
            for (int ai = 0; ai < 2; ++ai)
#pragma unroll
                for (int m = 0; m < 4; ++m) { const int row = row0 + ai * 128 + m * 16;
#pragma unroll
                    for (int bj = 0; bj < 2; ++bj) { f32x4 v0 = acc[ai][bj][m][0] * rs[ai][m], v1 = acc[ai][bj][m][1] * rs[ai][m];
                        if (act != 0) {
#pragma unroll
                            for (int j = 0; j < 4; ++j) { const float g0 = sigm(v0[j]), g1 = sigm(v1[j]); v0[j] = act == 1 ? v0[j] * g0 : g0; v1[j] = act == 1 ? v1[j] * g1 : g1; } }
                        *(u32x4*)(base + (size_t)row * ld + colt + bj * 128 + cw) = pack8(v0, v1); }
                    asm volatile("" ::: "memory"); }
        }
    }
};

struct Args { const void* in[23]; float* out; unsigned char* ws; int ph_lo, ph_hi; };

struct Ctx { LAS unsigned char* lds; int tid, lane, wave, G, bid; };

__device__ __forceinline__ void conv_matrix(const Ctx& C, const float* W, int K, int N, bf16_t* WT, int blk, int stride, int off, bool tiled = false) {
    LAS float* scr = (LAS float*)(C.lds + C.wave * 16384);
    const int gw = C.bid * NWAVES + C.wave, NGW = C.G * NWAVES, nblk = N / 32, nitems = (K / 64) * nblk, lane = C.lane;
    for (int item = gw; item < nitems; item += NGW) {
        const int kb = item / nblk, nb = item % nblk, k0 = 64 * kb, n0 = 32 * nb;
        float wv_[32];
#pragma unroll
        for (int i = 0; i < 32; ++i) wv_[i] = W[(size_t)(k0 + 2 * i + (lane >> 5)) * N + n0 + (lane & 31)];
#pragma unroll
        for (int i = 0; i < 32; ++i) scr[(2 * i + (lane >> 5)) * 33 + (lane & 31)] = wv_[i];
        asm volatile("s_waitcnt lgkmcnt(0)" ::: "memory");
        const int c = lane & 7;
#pragma unroll
        for (int j = 0; j < 4; ++j) { const int n = (lane >> 3) + 8 * j; const LAS float* s = scr + (8 * c) * 33 + n;
            u32x4 o; o.x = cvt_pk_bf16(s[0 * 33], s[1 * 33]); o.y = cvt_pk_bf16(s[2 * 33], s[3 * 33]); o.z = cvt_pk_bf16(s[4 * 33], s[5 * 33]); o.w = cvt_pk_bf16(s[6 * 33], s[7 * 33]);
            const int ng = n0 + n, drow = (ng / blk) * stride + off + (ng % blk);
            const size_t dst = tiled ? ((size_t)(drow >> 8) * (K >> 6) + (k0 >> 6)) * 16384 + (size_t)(drow & 255) * 64 + 8 * c : (size_t)drow * K + k0 + 8 * c;
            *(u32x4*)(WT + dst) = o; }
        asm volatile("s_waitcnt lgkmcnt(0)" ::: "memory");
    }
}
__device__ __forceinline__ void norm_rows_bf16(const Ctx& C, const float* X, const float* w, bf16_t* O) {
    const int gw = C.bid * NWAVES + C.wave, NGW = C.G * NWAVES, lane = C.lane;
    f32x4 wv[8];
#pragma unroll
    for (int j = 0; j < 8; ++j) wv[j] = *(const f32x4*)(w + 4 * lane + 256 * j);
    for (int m = gw; m < T; m += NGW) {
        const float* xr = X + (size_t)m * DM + 4 * lane; f32x4 v[8]; float s = 0.f;
#pragma unroll
        for (int j = 0; j < 8; ++j) { v[j] = *(const f32x4*)(xr + 256 * j); s += (v[j][0] * v[j][0] + v[j][1] * v[j][1]) + (v[j][2] * v[j][2] + v[j][3] * v[j][3]); }
        const float rstd = 1.0f / sqrtf(wave_sum(s) * (1.f / DM) + EPS);
        bf16_t* orow = O + (size_t)m * DM + 4 * lane;
#pragma unroll
        for (int j = 0; j < 8; ++j) { const f32x4 r = v[j] * rstd * wv[j]; u32x2 o; o.x = cvt_pk_bf16(r[0], r[1]); o.y = cvt_pk_bf16(r[2], r[3]); *(u32x2*)(orow + 256 * j) = o; }
    }
}
__device__ __forceinline__ void norm_rows_f32_inplace(const Ctx& C, float* X, const float* w) {
    const int gw = C.bid * NWAVES + C.wave, NGW = C.G * NWAVES, lane = C.lane;
    f32x4 wv[8];
#pragma unroll
    for (int j = 0; j < 8; ++j) wv[j] = *(const f32x4*)(w + 4 * lane + 256 * j);
    for (int m = gw; m < T; m += NGW) {
        float* xr = X + (size_t)m * DM + 4 * lane; f32x4 v[8]; float s = 0.f;
#pragma unroll
        for (int j = 0; j < 8; ++j) { v[j] = *(const f32x4*)(xr + 256 * j); s += (v[j][0] * v[j][0] + v[j][1] * v[j][1]) + (v[j][2] * v[j][2] + v[j][3] * v[j][3]); }
        const float rstd = 1.0f / sqrtf(wave_sum(s) * (1.f / DM) + EPS);
#pragma unroll
        for (int j = 0; j < 8; ++j) *(f32x4*)(xr + 256 * j) = v[j] * rstd * wv[j];
    }
}
__device__ __forceinline__ void rope_tables(const Ctx& C, const int* positions, float* rc, float* rs) {
    const float invf[8] = {1.0f, 0.1939227432012558f, 0.03760603070259094f, 0.007292664609849453f, 0.0014142135623842478f, 0.00027424818836152554f, 5.318296098266728e-05f, 1.0313386155758053e-05f};
    for (int idx = C.bid * NTHREADS + C.tid; idx < T * 8; idx += C.G * NTHREADS) {
        const int t = idx >> 3, i = idx & 7;
        float f = invf[0];
#pragma unroll
        for (int k = 1; k < 8; ++k) f = (i == k) ? invf[k] : f;
        const float ang = (float)positions[t] * f;
        double rev = (double)ang * 0.15915494309189535; rev -= __builtin_rint(rev);
        const float r = (float)rev;
        rc[idx] = __builtin_amdgcn_cosf(r); rs[idx] = __builtin_amdgcn_sinf(r);
    }
}
__device__ __forceinline__ void conv_p(const Ctx& C, const float* p, bf16_t* pb) {
    for (size_t i = (size_t)(C.bid * NTHREADS + C.tid) * 8; i < (size_t)T * PLE; i += (size_t)C.G * NTHREADS * 8) {
        const f32x4 a = *(const f32x4*)(p + i), b = *(const f32x4*)(p + i + 4); *(u32x4*)(pb + i) = pack8(a, b); }
}

__device__ __forceinline__ void attn_phase(const Ctx& C, const bf16_t* Q, const bf16_t* K, const bf16_t* V, const float* sinks, bf16_t* O) {
    const int tid = C.tid, lane = C.lane, w = C.wave, fr = lane & 15, fq = lane >> 4;
    LAS bf16_t* Ks = (LAS bf16_t*)C.lds;
    LAS bf16_t* Vt = (LAS bf16_t*)(C.lds + 36864);
    LAS bf16_t* Pw = (LAS bf16_t*)(C.lds + 36864 + 33792 + w * 8448);
    for (int unit = C.bid; unit < 512; unit += C.G) {
        const int n = unit & 31, kvh = (unit >> 5) & 3, b = unit >> 7;
        u32x4 kq[4], vq[4];
#pragma unroll
        for (int i = 0; i < 4; ++i) { const int ch = tid + 512 * i, j = ch >> 3, c8 = (ch & 7) * 8, pos = (n - 1) * 128 + j, posc = pos < 0 ? 0 : pos;
            const size_t g = ((size_t)(b * SEQ + posc)) * 256 + kvh * 64 + c8; kq[i] = *(const u32x4*)(K + g); vq[i] = *(const u32x4*)(V + g); }
        bf16x8 qfa[4][2]; float sk[4];
#pragma unroll
        for (int g = 0; g < 4; ++g) { const bf16_t* qp = Q + (size_t)(b * SEQ + n * 128 + 16 * w + fr) * 1024 + (kvh * 4 + g) * 64 + 8 * fq;
            qfa[g][0] = *(const bf16x8*)qp; qfa[g][1] = *(const bf16x8*)(qp + 32); sk[g] = sinks[kvh * 4 + g]; }
        __syncthreads();
#pragma unroll
        for (int i = 0; i < 4; ++i) {
            const int ch = tid + 512 * i, j = ch >> 3, c8 = (ch & 7) * 8, pos = (n - 1) * 128 + j;
            u32x4 kv = kq[i], vv = vq[i];
            if (pos < 0) { kv = (u32x4){0u, 0u, 0u, 0u}; vv = kv; }
            *(LAS u32x4*)(Ks + j * 72 + c8) = kv;
            Vt[(c8 + 0) * 264 + j] = (bf16_t)(vv.x & 0xffffu); Vt[(c8 + 1) * 264 + j] = (bf16_t)(vv.x >> 16);
            Vt[(c8 + 2) * 264 + j] = (bf16_t)(vv.y & 0xffffu); Vt[(c8 + 3) * 264 + j] = (bf16_t)(vv.y >> 16);
            Vt[(c8 + 4) * 264 + j] = (bf16_t)(vv.z & 0xffffu); Vt[(c8 + 5) * 264 + j] = (bf16_t)(vv.z >> 16);
            Vt[(c8 + 6) * 264 + j] = (bf16_t)(vv.w & 0xffffu); Vt[(c8 + 7) * 264 + j] = (bf16_t)(vv.w >> 16);
        }
        __syncthreads();
        const int t0 = w & ~1;
#pragma unroll
        for (int g = 0; g < 4; ++g) {
            const int head = kvh * 4 + g;
            const bf16x8 qf0 = qfa[g][0], qf1 = qfa[g][1];
            f32x4 s[10];
            {
                bf16x8 kf[10][2];
#pragma unroll
                for (int i = 0; i < 10; ++i) { const LAS bf16_t* kp = Ks + (16 * (t0 + i) + fr) * 72 + 8 * fq; kf[i][0] = *(const LAS bf16x8*)kp; kf[i][1] = *(const LAS bf16x8*)(kp + 32); }
                __builtin_amdgcn_sched_barrier(0);
#pragma unroll
                for (int i = 0; i < 10; ++i) { f32x4 a = {0.f, 0.f, 0.f, 0.f}; a = MFMA16(qf0, kf[i][0], a); a = MFMA16(qf1, kf[i][1], a); s[i] = a; }
            }
            const float sink2 = sk[g] * LOG2E;
            float mx[4] = {sink2, sink2, sink2, sink2};
#pragma unroll
            for (int i = 0; i < 10; ++i)
#pragma unroll
                for (int r = 0; r < 4; ++r) { const int j = 16 * (t0 + i) + fr, dist = 16 * w + 4 * fq + r + 128 - j;
                    const bool ok = (dist >= 0) && (dist < 128) && (n > 0 || j >= 128);
                    const float v = ok ? s[i][r] : -INFINITY; s[i][r] = v; mx[r] = fmaxf(mx[r], v); if (r == 3) __builtin_amdgcn_sched_barrier(0); }
            float sum[4], inv[4];
#pragma unroll
            for (int r = 0; r < 4; ++r) { mx[r] = grp16_max(mx[r]); sum[r] = 0.f; }
#pragma unroll
            for (int i = 0; i < 10; ++i)
#pragma unroll
                for (int r = 0; r < 4; ++r) { const float e = ex2(s[i][r] - mx[r]); s[i][r] = e; sum[r] += e; }
#pragma unroll
            for (int r = 0; r < 4; ++r) { sum[r] = grp16_sum(sum[r]) + ex2(sink2 - mx[r]); inv[r] = 1.0f / sum[r]; }
#pragma unroll
            for (int i = 0; i < 10; ++i)
#pragma unroll
                for (int r = 0; r < 4; ++r) Pw[(4 * fq + r) * 264 + 16 * (t0 + i) + fr] = f2bf(s[i][r] * inv[r]);
            asm volatile("s_waitcnt lgkmcnt(0)" ::: "memory");
            f32x4 o[4];
#pragma unroll
            for (int dt = 0; dt < 4; ++dt) o[dt] = (f32x4){0.f, 0.f, 0.f, 0.f};
            {
                bf16x8 pa[5], vf[5][4];
#pragma unroll
                for (int ks = 0; ks < 5; ++ks) { pa[ks] = *(const LAS bf16x8*)(Pw + fr * 264 + 16 * t0 + 32 * ks + 8 * fq);
#pragma unroll
                    for (int dt = 0; dt < 4; ++dt) vf[ks][dt] = *(const LAS bf16x8*)(Vt + (16 * dt + fr) * 264 + 16 * t0 + 32 * ks + 8 * fq); }
                __builtin_amdgcn_sched_barrier(0);
#pragma unroll
                for (int ks = 0; ks < 5; ++ks)
#pragma unroll
                    for (int dt = 0; dt < 4; ++dt) o[dt] = MFMA16(pa[ks], vf[ks][dt], o[dt]);
            }
#pragma unroll
            for (int dt = 0; dt < 4; ++dt)
#pragma unroll
                for (int r = 0; r < 4; ++r) Pw[(4 * fq + r) * 264 + 16 * dt + fr] = f2bf(o[dt][r]);
            asm volatile("s_waitcnt lgkmcnt(0)" ::: "memory");
            { const int orow = lane >> 2, oc = (lane & 3) * 16;
              const u32x4 w0 = *(const LAS u32x4*)(Pw + orow * 264 + oc), w1 = *(const LAS u32x4*)(Pw + orow * 264 + oc + 8);
              bf16_t* op = O + (size_t)(b * SEQ + n * 128 + 16 * w + orow) * 1024 + head * 64 + oc;
              *(u32x4*)op = w0; *(u32x4*)(op + 8) = w1; }
            asm volatile("s_waitcnt lgkmcnt(0)" ::: "memory");
        }
    }
}

#define HG_CUMSUM(LOGF, row0, h, TOT) \
    const int d = tid & 127, part = tid >> 7; float lf[16], cu[16]; \
    { float run = 0.f; _Pragma("unroll") for (int i = 0; i < 16; ++i) { lf[i] = LOGF[(size_t)(row0 + 16 * part + i) * 1024 + h * 128 + d]; run += lf[i]; cu[i] = run; } \
      TOT[part * 128 + d] = run; } \
    __syncthreads(); \
    float last, pre = 0.f; { const float t0_ = TOT[d], t1_ = TOT[128 + d], t2_ = TOT[256 + d], t3_ = TOT[384 + d]; last = (t0_ + t1_) + (t2_ + t3_); \
      pre = part == 0 ? 0.f : (part == 1 ? t0_ : (part == 2 ? t0_ + t1_ : (t0_ + t1_) + t2_)); } \
    _Pragma("unroll") for (int i = 0; i < 16; ++i) cu[i] += pre;

__device__ __forceinline__ void pack16_store(LAS bf16_t* dst, const float (&v)[16]) {
    u32x4 a, b; a.x = cvt_pk_bf16(v[0], v[1]); a.y = cvt_pk_bf16(v[2], v[3]); a.z = cvt_pk_bf16(v[4], v[5]); a.w = cvt_pk_bf16(v[6], v[7]);
    b.x = cvt_pk_bf16(v[8], v[9]); b.y = cvt_pk_bf16(v[10], v[11]); b.z = cvt_pk_bf16(v[12], v[13]); b.w = cvt_pk_bf16(v[14], v[15]);
    *(LAS u32x4*)dst = a; *(LAS u32x4*)(dst + 8) = b;
}
__device__ __forceinline__ void hgrn_pass1(const Ctx& C, const float* LOGF, const bf16_t* IB, bf16_t* STATE, float* DECAY) {
    const int tid = C.tid, lane = C.lane, w = C.wave, fr = lane & 15, fq = lane >> 4;
    LAS bf16_t* KbT = (LAS bf16_t*)C.lds;
    LAS bf16_t* VT = (LAS bf16_t*)(C.lds + 18432);
    LAS float* TOT = (LAS float*)(C.lds + 36864);
    for (int unit = C.bid; unit < 2048; unit += C.G) {
        const int b = unit >> 9, h = (unit >> 6) & 7, c = unit & 63, row0 = b * SEQ + c * 64;
        __syncthreads();
        HG_CUMSUM(LOGF, row0, h, TOT)
        float kb[16], vv[16];
#pragma unroll
        for (int i = 0; i < 16; ++i) { kb[i] = (1.f - ex2(lf[i])) * ex2(last - cu[i]); vv[i] = bf2f(IB[(size_t)(row0 + 16 * part + i) * 1024 + h * 128 + d]); }
        pack16_store(KbT + d * 72 + 16 * part, kb); pack16_store(VT + d * 72 + 16 * part, vv);
        if (part == 0) DECAY[(size_t)unit * 128 + d] = ex2(last);
        __syncthreads();
        bf16x8 a0 = *(const LAS bf16x8*)(KbT + (16 * w + fr) * 72 + 8 * fq), a1 = *(const LAS bf16x8*)(KbT + (16 * w + fr) * 72 + 32 + 8 * fq);
        bf16x8 vb[8][2];
#pragma unroll
        for (int et = 0; et < 8; ++et) { vb[et][0] = *(const LAS bf16x8*)(VT + (16 * et + fr) * 72 + 8 * fq); vb[et][1] = *(const LAS bf16x8*)(VT + (16 * et + fr) * 72 + 32 + 8 * fq); }
        __builtin_amdgcn_sched_barrier(0);
#pragma unroll
        for (int et = 0; et < 8; ++et) { f32x4 acc = {0.f, 0.f, 0.f, 0.f};
            acc = MFMA16(a0, vb[et][0], acc); acc = MFMA16(a1, vb[et][1], acc);
            u32x2 o; o.x = cvt_pk_bf16(acc[0], acc[1]); o.y = cvt_pk_bf16(acc[2], acc[3]);
            *(u32x2*)(STATE + (size_t)unit * 16384 + (16 * et + fr) * 128 + 16 * w + 4 * fq) = o; }
    }
}
__device__ __forceinline__ void hgrn_pass2(const Ctx& C, bf16_t* STATE, const float* DECAY) {
    for (int idx = C.bid * NTHREADS + C.tid; idx < 32 * 4096; idx += C.G * NTHREADS) {
        const int bh = idx >> 12, el = (idx & 4095) * 4; f32x4 s = {0.f, 0.f, 0.f, 0.f};
#pragma unroll 4
        for (int c = 0; c < 64; ++c) { const size_t unit = (size_t)bh * 64 + c; bf16_t* p = STATE + unit * 16384 + el;
            const u32x2 raw = *(const u32x2*)p; const f32x4 dec = *(const f32x4*)(DECAY + unit * 128 + (el & 127));
            u32x2 o; o.x = cvt_pk_bf16(s[0], s[1]); o.y = cvt_pk_bf16(s[2], s[3]); *(u32x2*)p = o;
            const f32x4 dl = (f32x4){bflo(raw.x), bfhi(raw.x), bflo(raw.y), bfhi(raw.y)}; s = dec * s + dl; }
    }
}
__device__ __forceinline__ void hgrn_pass3(const Ctx& C, const float* LOGF, const bf16_t* QB, const bf16_t* IB, const bf16_t* OG, const bf16_t* STATE, const float* hnorm, bf16_t* OUTB) {
    const int tid = C.tid, lane = C.lane, w = C.wave, fr = lane & 15, fq = lane >> 4;
    LAS bf16_t* Qt = (LAS bf16_t*)C.lds;
    LAS bf16_t* Kt = (LAS bf16_t*)(C.lds + 17408);
    LAS bf16_t* VT = (LAS bf16_t*)(C.lds + 34816);
    LAS bf16_t* ST = (LAS bf16_t*)(C.lds + 53248);
    LAS bf16_t* Am = (LAS bf16_t*)(C.lds + 88064);
    LAS float* TOT = (LAS float*)(C.lds + 97280);
    LAS float* SSQ = (LAS float*)(C.lds + 99328);
    for (int unit = C.bid; unit < 2048; unit += C.G) {
        const int b = unit >> 9, h = (unit >> 6) & 7, c = unit & 63, row0 = b * SEQ + c * 64;
        __syncthreads();
        {
            HG_CUMSUM(LOGF, row0, h, TOT)
            float vv[16];
#pragma unroll
            for (int i = 0; i < 16; ++i) { const size_t g = (size_t)(row0 + 16 * part + i) * 1024 + h * 128 + d;
                const float qs = bf2f(QB[g]); vv[i] = bf2f(IB[g]);
                Qt[(16 * part + i) * 136 + d] = f2bf(qs * ex2(cu[i])); Kt[(16 * part + i) * 136 + d] = f2bf((1.f - ex2(lf[i])) * ex2(-cu[i])); }
            pack16_store(VT + d * 72 + 16 * part, vv);
#pragma unroll
            for (int i = 0; i < 4; ++i) { const int ch = tid + 512 * i, e = ch >> 4, c8 = (ch & 15) * 8; *(LAS u32x4*)(ST + e * 136 + c8) = *(const u32x4*)(STATE + (size_t)unit * 16384 + e * 128 + c8); }
        }
        __syncthreads();
        const int tt = w >> 1;
        {
            bf16x8 qa[4];
#pragma unroll
            for (int ks = 0; ks < 4; ++ks) qa[ks] = *(const LAS bf16x8*)(Qt + (16 * tt + fr) * 136 + 32 * ks + 8 * fq);
            bf16x8 kb2[2][4];
#pragma unroll
            for (int s2 = 0; s2 < 2; ++s2)
#pragma unroll
                for (int ks = 0; ks < 4; ++ks) kb2[s2][ks] = *(const LAS bf16x8*)(Kt + (16 * (2 * (w & 1) + s2) + fr) * 136 + 32 * ks + 8 * fq);
            __builtin_amdgcn_sched_barrier(0);
#pragma unroll
            for (int s2 = 0; s2 < 2; ++s2) { const int st = 2 * (w & 1) + s2; f32x4 acc = {0.f, 0.f, 0.f, 0.f};
#pragma unroll
                for (int ks = 0; ks < 4; ++ks) acc = MFMA16(qa[ks], kb2[s2][ks], acc);
#pragma unroll
                for (int r = 0; r < 4; ++r) { const int t = 16 * tt + 4 * fq + r, s = 16 * st + fr; Am[t * 72 + s] = f2bf(s <= t ? acc[r] : 0.f); } }
        }
        __syncthreads();
        f32x4 o[4]; float pr[4] = {0.f, 0.f, 0.f, 0.f};
        {
            bf16x8 am[2], qa[4];
#pragma unroll
            for (int ks = 0; ks < 2; ++ks) am[ks] = *(const LAS bf16x8*)(Am + (16 * tt + fr) * 72 + 32 * ks + 8 * fq);
#pragma unroll
            for (int ks = 0; ks < 4; ++ks) qa[ks] = *(const LAS bf16x8*)(Qt + (16 * tt + fr) * 136 + 32 * ks + 8 * fq);
            bf16x8 vtf[4][2], stf[4][4];
#pragma unroll
            for (int j = 0; j < 4; ++j) { const int et = 4 * (w & 1) + j;
#pragma unroll
                for (int ks = 0; ks < 2; ++ks) vtf[j][ks] = *(const LAS bf16x8*)(VT + (16 * et + fr) * 72 + 32 * ks + 8 * fq);
#pragma unroll
                for (int ks = 0; ks < 4; ++ks) stf[j][ks] = *(const LAS bf16x8*)(ST + (16 * et + fr) * 136 + 32 * ks + 8 * fq); }
            __builtin_amdgcn_sched_barrier(0);
#pragma unroll
            for (int j = 0; j < 4; ++j) { f32x4 acc = {0.f, 0.f, 0.f, 0.f};
#pragma unroll
                for (int ks = 0; ks < 2; ++ks) acc = MFMA16(am[ks], vtf[j][ks], acc);
#pragma unroll
                for (int ks = 0; ks < 4; ++ks) acc = MFMA16(qa[ks], stf[j][ks], acc);
                o[j] = acc;
#pragma unroll
                for (int r = 0; r < 4; ++r) pr[r] += acc[r] * acc[r]; }
        }
#pragma unroll
        for (int r = 0; r < 4; ++r) { pr[r] = grp16_sum(pr[r]); if (fr == 0) SSQ[(16 * tt + 4 * fq + r) * 2 + (w & 1)] = pr[r]; }
        __syncthreads();
        float hn[4]; unsigned ogr[4][4];
#pragma unroll
        for (int j = 0; j < 4; ++j) hn[j] = hnorm[h * 128 + 16 * (4 * (w & 1) + j) + fr];
#pragma unroll
        for (int r = 0; r < 4; ++r)
#pragma unroll
            for (int j = 0; j < 4; ++j) ogr[r][j] = OG[(size_t)(row0 + 16 * tt + 4 * fq + r) * 1024 + h * 128 + 16 * (4 * (w & 1) + j) + fr];
        LAS bf16_t* Ow = (LAS bf16_t*)(C.lds + 100352 + w * 2304);
#pragma unroll
        for (int r = 0; r < 4; ++r) { const int t = 16 * tt + 4 * fq + r; const float rstd = 1.0f / sqrtf((SSQ[t * 2] + SSQ[t * 2 + 1]) * (1.f / 128.f) + EPS);
#pragma unroll
            for (int j = 0; j < 4; ++j) Ow[(4 * fq + r) * 72 + 16 * j + fr] = f2bf(o[j][r] * rstd * hn[j] * bf2f(ogr[r][j])); }
        asm volatile("s_waitcnt lgkmcnt(0)" ::: "memory");
        { const int orow = lane >> 2, oc = (lane & 3) * 16;
          const u32x4 w0 = *(const LAS u32x4*)(Ow + orow * 72 + oc), w1 = *(const LAS u32x4*)(Ow + orow * 72 + oc + 8);
          bf16_t* op = OUTB + (size_t)(row0 + 16 * tt + orow) * 1024 + h * 128 + 64 * (w & 1) + oc;
          *(u32x4*)op = w0; *(u32x4*)(op + 8) = w1; }
    }
}


#define XB_TMO      128
#define XB_XCNT(j)  (256  + 64 * (j))
#define XB_XSUB(j)  (1280 + 64 * (j))
#define XB_XGEN(j)  (2304 + 64 * (j))
#define XB_TOP      3328
#define XB_TOPGEN   3392
#define XCD_BAR_WORDS 3456
#define XB_SPIN_CAP (1u << 18)
__device__ __forceinline__ unsigned xb_ld(unsigned* p)              { return __hip_atomic_load(p, __ATOMIC_RELAXED, __HIP_MEMORY_SCOPE_AGENT); }
__device__ __forceinline__ unsigned xb_add(unsigned* p, unsigned v) { return __hip_atomic_fetch_add(p, v, __ATOMIC_RELAXED, __HIP_MEMORY_SCOPE_AGENT); }
__device__ __forceinline__ unsigned xb_xcc_id() { return (unsigned)__builtin_amdgcn_s_getreg((3 << 11) | 20) & 0xFu; }
#define XB_SPIN(cond, bar) do { unsigned _sp = 0; while (cond) { __builtin_amdgcn_s_sleep(1); \
    if ((++_sp & 255u) == 0u) { if (xb_ld(&(bar)[XB_TMO])) break; if (_sp > XB_SPIN_CAP) { atomicAdd(&(bar)[XB_TMO], 1u); break; } } } } while (0)
struct XcdBarrier { unsigned* bar; unsigned x; volatile LAS unsigned* st; };
__device__ __forceinline__ XcdBarrier xcd_barrier_post(unsigned* bar, volatile LAS unsigned* st) {
    XcdBarrier b; b.bar = bar; b.x = xb_xcc_id(); b.st = st;
    if (threadIdx.x == 0) st[2] = xb_add(&bar[XB_XCNT(b.x)], 1u);
    return b;
}
__device__ __forceinline__ void xcd_barrier_complete(unsigned* bar, unsigned x, unsigned& nloc, unsigned& nx) {
    const unsigned G = gridDim.x * gridDim.y * gridDim.z;
    unsigned sum, cnt, mine, sp = 0u;
    for (;;) {
        sum = 0u; cnt = 0u; mine = 0u;
#pragma unroll
        for (unsigned j = 0; j < 16; ++j) { const unsigned c = xb_ld(&bar[XB_XCNT(j)]); sum += c; cnt += (c > 0u) ? 1u : 0u; mine = (j == x) ? c : mine; }
        if (sum == G) break;
        __builtin_amdgcn_s_sleep(1);
        if ((++sp & 255u) == 0u) { if (xb_ld(&bar[XB_TMO])) break; if (sp > XB_SPIN_CAP) { atomicAdd(&bar[XB_TMO], 1u); break; } }
    }
    nloc = mine > 0u ? mine : 1u; nx = cnt > 0u ? cnt : 1u;
}
__device__ __forceinline__ void xcd_barrier(const XcdBarrier& b) {
    asm volatile("s_waitcnt vmcnt(0)" ::: "memory");
    __syncthreads();
    if (threadIdx.x == 0) {
        unsigned* bar = b.bar;
        __builtin_amdgcn_s_waitcnt(0);
        unsigned nloc = b.st[0], nx = b.st[1];
        if (nloc == 0u) { xcd_barrier_complete(bar, b.x, nloc, nx); b.st[0] = nloc; b.st[1] = nx; }
        const unsigned old = xb_add(&bar[XB_XSUB(b.x)], 1u);
        const unsigned gen = old / nloc;
        if (old + 1u == (gen + 1u) * nloc) {
            __builtin_amdgcn_fence(__ATOMIC_RELEASE, "agent");
            asm volatile("s_waitcnt vmcnt(0)" ::: "memory");
            const unsigned og = xb_add(&bar[XB_TOP], 1u);
            const unsigned tg = og / nx;
            if (og + 1u == (tg + 1u) * nx) xb_add(&bar[XB_TOPGEN], 1u);
            else XB_SPIN(xb_ld(&bar[XB_TOPGEN]) == tg, bar);
            __builtin_amdgcn_fence(__ATOMIC_ACQUIRE, "agent");
            xb_add(&bar[XB_XGEN(b.x)], 1u);
            asm volatile("s_waitcnt vmcnt(0)" ::: "memory");
        } else {
            XB_SPIN(xb_ld(&bar[XB_XGEN(b.x)]) == gen, bar);
            __builtin_amdgcn_fence(__ATOMIC_ACQUIRE, "agent");
            asm volatile("s_waitcnt vmcnt(0)" ::: "memory");
        }
    }
    __syncthreads();
}
__global__ void __launch_bounds__(NTHREADS, 2) mega_fwd(Args args) {
    extern __shared__ __attribute__((aligned(16))) unsigned char lds_raw[];
    cg::grid_group grid = cg::this_grid();
    Ctx C; C.lds = (LAS unsigned char*)lds_raw; C.tid = threadIdx.x; C.lane = C.tid & 63; C.wave = __builtin_amdgcn_readfirstlane(C.tid >> 6); C.G = gridDim.x; C.bid = blockIdx.x;
    unsigned char* const ws = args.ws;
#define PX ((const float*)args.in[0])
#define POUT (args.out)
#define P_ROPEC ((float*)(ws + WS_ROPE))
#define P_ROPES ((float*)(ws + WS_ROPE) + T * 8)
#define WGU ((bf16_t*)(ws + WS_WA_GU))
#define WD ((bf16_t*)(ws + WS_WA_D))
#define WIN ((bf16_t*)(ws + WS_WIN))
#define WUA ((bf16_t*)(ws + WS_WUA))
#define WUB ((bf16_t*)(ws + WS_WUB))
#define WOUT ((bf16_t*)(ws + WS_WOUT))
#define WPG ((bf16_t*)(ws + WS_WPG))
#define WPP ((bf16_t*)(ws + WS_WPP))
#define H ((bf16_t*)(ws + WS_H))
#define ACT ((bf16_t*)(ws + WS_ACT))
#define Qb ((bf16_t*)(ws + WS_Q))
#define Kb ((bf16_t*)(ws + WS_K))
#define Vb ((bf16_t*)(ws + WS_V))
#define QB ((bf16_t*)(ws + WS_QB))
#define IB ((bf16_t*)(ws + WS_IB))
#define OG ((bf16_t*)(ws + WS_OG))
#define GA ((bf16_t*)(ws + WS_GA))
#define GB ((bf16_t*)(ws + WS_GB))
#define LOGF ((float*)(ws + WS_LOGF))
#define OUTA ((bf16_t*)(ws + WS_OUTA))
#define OUTB ((bf16_t*)(ws + WS_OUTB))
#define STATE ((bf16_t*)(ws + WS_STATE))
#define DECAY ((float*)(ws + WS_DECAY))
#define PBF ((bf16_t*)(ws + WS_PBF))
#define PP ((bf16_t*)(ws + WS_PP))
#define SSQ0 ((float*)(ws + WS_SS))
    volatile LAS unsigned* xst = (volatile LAS unsigned*)(C.lds + LDS_BYTES - 64);
    if (C.tid < 4) xst[C.tid] = 0u;
    __syncthreads();
    if (args.ph_hi - args.ph_lo > 1) {
        if (C.bid == 0) { unsigned* bw = (unsigned*)(ws + WS_BAR); for (int i = C.tid; i < 4096; i += NTHREADS) bw[i] = 0u; }
        asm volatile("s_waitcnt vmcnt(0)" ::: "memory");
        grid.sync(); }
    const XcdBarrier xbar = xcd_barrier_post((unsigned*)(ws + WS_BAR), xst);
    const int lo = args.ph_lo, hi = args.ph_hi;
#ifndef PHASE_MASK
#define PHASE_MASK 0xffff
#endif
#define IN(k) ((((PHASE_MASK) >> (k)) & 1) && lo <= (k) && (k) < hi)
#define SEAM(k) do { if (IN(k) && IN((k) + 1)) { asm volatile("s_waitcnt vmcnt(0) lgkmcnt(0)" ::: "memory"); xcd_barrier(xbar); } } while (0)
    pg8::StaticOrder S;

    if (IN(0)) {
        for (int i = C.bid * NTHREADS + C.tid; i < 4 * T; i += C.G * NTHREADS) SSQ0[i] = 0.f;
        conv_matrix(C, (const float*)args.in[4], DM, FF, WGU, 128, 256, 0);
        conv_matrix(C, (const float*)args.in[5], DM, FF, WGU, 128, 256, 128);
        conv_matrix(C, (const float*)args.in[6], FF, DM, WD, DM, 0, 0, true);
        conv_matrix(C, (const float*)args.in[8], DM, IND, WIN, IND, 0, 0);
        conv_matrix(C, (const float*)args.in[12], 1024, DM, WUA, DM, 0, 0);
        conv_matrix(C, (const float*)args.in[13], 1024, DM, WUB, DM, 0, 0);
        conv_matrix(C, (const float*)args.in[14], DM, DM, WOUT, DM, 0, 0);
        conv_matrix(C, (const float*)args.in[20], DM, DM, WPG, DM, 0, 0);
        conv_matrix(C, (const float*)args.in[21], PLE, DM, WPP, DM, 0, 0);
        rope_tables(C, (const int*)args.in[2], P_ROPEC, P_ROPES);
        norm_rows_bf16(C, PX, (const float*)args.in[3], H);
    }
    SEAM(0);
    int gbid = C.bid;
    {
        if (C.tid == 0) { unsigned* bar = (unsigned*)(ws + WS_BAR); bool ok = (C.G % 8) == 0;
            for (unsigned j = 0; j < 16; ++j) { const unsigned c = xb_ld(&bar[XB_XCNT(j)]); ok = ok && (c == (j < 8 ? (unsigned)C.G / 8u : 0u)); }
            xst[3] = ok ? (xst[2] * 8u + xbar.x) : (unsigned)C.bid; }
        __syncthreads();
        gbid = (int)xst[3];
    }
    if (IN(1)) { pg8::Gemm g{H, WGU, T, 2 * FF, DM}; S.init(T, 2 * FF, C.G, gbid); EpiSwiGLU E{ACT, nullptr}; pg8::gemm_phase(C.lds, g, S, E); }
    SEAM(1);
    if (IN(2)) { pg8::Gemm g{ACT, WD, T, DM, FF}; S.init(T, DM, C.G, gbid); EpiResidNorm E{PX, POUT, 0.5f, (const float*)args.in[7], H, SSQ0}; pg8::gemm_phase<EpiResidNorm, true, true>(C.lds, g, S, E); }
    SEAM(2);
    if (IN(3)) { pg8::Gemm g{H, WIN, T, IND, DM}; S.init(T, IND, C.G, gbid);
        EpiProj E{Qb, Kb, Vb, QB, IB, OG, GA, GB, LOGF, P_ROPEC, P_ROPES, (const float*)args.in[10], SSQ0}; pg8::gemm_phase(C.lds, g, S, E); }
    SEAM(3);
    if (IN(4)) { attn_phase(C, Qb, Kb, Vb, (const float*)args.in[9], OUTA); hgrn_pass1(C, LOGF, IB, STATE, DECAY); }
    SEAM(4);
    if (IN(5)) { hgrn_pass2(C, STATE, DECAY); __syncthreads();
        pg8::Gemm g{OUTA, WUA, T, DM, 1024}; S.init(T, DM, C.G, gbid); EpiBf<1> E{GA, nullptr}; pg8::gemm_phase(C.lds, g, S, E); }
    SEAM(5);
    if (IN(6)) hgrn_pass3(C, LOGF, QB, IB, OG, STATE, (const float*)args.in[11], OUTB);
    SEAM(6);
    if (IN(7)) {
        conv_matrix(C, (const float*)args.in[16], DM, FF, WGU, 128, 256, 0);
        conv_matrix(C, (const float*)args.in[17], DM, FF, WGU, 128, 256, 128);
        conv_matrix(C, (const float*)args.in[18], FF, DM, WD, DM, 0, 0, true);
        conv_p(C, (const float*)args.in[1], PBF); __syncthreads();
        pg8::Gemm g{OUTB, WUB, T, DM, 1024}; S.init(T, DM, C.G, gbid); EpiBf<2> E{GB, GA}; pg8::gemm_phase(C.lds, g, S, E); }
    SEAM(7);
    if (IN(8)) { pg8::Gemm g{GB, WOUT, T, DM, DM}; S.init(T, DM, C.G, gbid); EpiResidNorm E{POUT, POUT, 1.0f, (const float*)args.in[15], H, SSQ0 + T}; pg8::gemm_phase(C.lds, g, S, E); }
    SEAM(8);
    if (IN(9)) { { pg8::Gemm g{PBF, WPP, T, DM, PLE}; S.init(T, DM, C.G, gbid); EpiBf<0> E{PP, nullptr}; pg8::gemm_phase(C.lds, g, S, E); }
        pg8::Gemm g{H, WGU, T, 2 * FF, DM}; S.init(T, 2 * FF, C.G, gbid); EpiSwiGLU E{ACT, SSQ0 + T}; pg8::gemm_phase(C.lds, g, S, E); }
    SEAM(9);
    if (IN(10)) { pg8::Gemm g{ACT, WD, T, DM, FF}; S.init(T, DM, C.G, gbid); EpiResidNorm E{POUT, POUT, 0.5f, (const float*)args.in[19], H, SSQ0 + 2 * T}; pg8::gemm_phase<EpiResidNorm, true, true>(C.lds, g, S, E); }
    SEAM(10);
    if (IN(11)) { pg8::Gemm g{H, WPG, T, DM, DM}; S.init(T, DM, C.G, gbid, 4);
        EpiPleFinal E{POUT, POUT, PP, SSQ0 + 2 * T, SSQ0 + 3 * T, (unsigned*)(ws + WS_BAR) + 3584, (const float*)args.in[22]}; pg8::gemm_phase(C.lds, g, S, E); }
#undef IN
#undef SEAM
}

#ifndef PH_RUN
#define PH_RUN 0xffff
#endif
#ifndef DUP_MASK
#define DUP_MASK 0x0
#endif
#ifndef MK_PER_PHASE
#define MK_PER_PHASE 0
#endif
extern "C" void kernel_launch(void* const* d_in, const int* in_sizes, int n_in, void* d_out, int out_size, void* d_ws, size_t ws_size, hipStream_t stream) {
    static int grid = 0;
    if (grid == 0) {
        if (n_in != 23 || out_size != T * DM || ws_size < WS_END) { fprintf(stderr, "kernel_launch: unexpected problem (n_in %d, out %d, ws %zu)\n", n_in, out_size, ws_size); grid = -1; return; }
        int dev = 0, cus = 0, per_cu = 0;
        (void)hipGetDevice(&dev); (void)hipDeviceGetAttribute(&cus, hipDeviceAttributeMultiprocessorCount, dev);
        if (hipFuncSetAttribute((const void*)mega_fwd, hipFuncAttributeMaxDynamicSharedMemorySize, LDS_BYTES) != hipSuccess) { fprintf(stderr, "kernel_launch: hipFuncSetAttribute failed\n"); grid = -1; return; }
        if (hipOccupancyMaxActiveBlocksPerMultiprocessor(&per_cu, (const void*)mega_fwd, NTHREADS, LDS_BYTES) != hipSuccess || per_cu < 1) per_cu = 1;
        (void)hipGetLastError();
        grid = cus > 0 ? cus : 256;
    }
    if (grid < 0) return;
    Args a{};
    for (int i = 0; i < 23; ++i) a.in[i] = d_in[i];
    a.out = (float*)d_out; a.ws = (unsigned char*)d_ws;
#if MK_PER_PHASE
    for (int ph = 0; ph < 13; ++ph) { if (!((PH_RUN >> ph) & 1)) continue; a.ph_lo = ph; a.ph_hi = ph + 1; for (int rep = 0; rep < (((DUP_MASK >> ph) & 1) ? 2 : 1); ++rep) hipLaunchKernelGGL(mega_fwd, dim3(grid), dim3(NTHREADS), LDS_BYTES, stream, a); }
#else
    a.ph_lo = 0; a.ph_hi = 12;
    void* kargs[] = {&a};
    hipError_t e = hipLaunchCooperativeKernel((const void*)mega_fwd, dim3(grid), dim3(NTHREADS), kargs, LDS_BYTES, stream);
    if (e != hipSuccess) fprintf(stderr, "cooperative launch failed: %s (grid %d)\n", hipGetErrorString(e), grid);
#endif
}
```

```cpp
#include <hip/hip_runtime.h>
#include <hip/hip_cooperative_groups.h>
#include <cstdio>
#include <cstdint>
namespace cg = cooperative_groups;

#define LAS __attribute__((address_space(3)))
typedef unsigned short bf16_t;
typedef short bf16x8 __attribute__((ext_vector_type(8)));
typedef float f32x4 __attribute__((ext_vector_type(4)));
typedef unsigned u32x4 __attribute__((ext_vector_type(4)));
typedef unsigned u32x2 __attribute__((ext_vector_type(2)));

constexpr int NBATCH = 4, SEQ = 4096, T = NBATCH * SEQ, DM = 2048, FF = 5632, IND = 9728, PLE = 256;
constexpr float EPS = 1e-6f;
constexpr float LOG2E = 1.4426950408889634f;
constexpr float QSCALE = 0.125f * LOG2E;
constexpr int NWAVES = 8, NTHREADS = NWAVES * 64;
constexpr int LDS_BYTES = 147456;

constexpr size_t MiB = 1u << 20;
constexpr size_t WS_ROPE = 0;
constexpr size_t WS_WA_GU = 1 * MiB, WS_WA_D = 45 * MiB;
constexpr size_t WS_STATE = 1 * MiB;
constexpr size_t WS_WIN = 67 * MiB;
constexpr size_t WS_PBF = 67 * MiB, WS_DECAY = 75 * MiB;
constexpr size_t WS_WUA = 105 * MiB, WS_WUB = 109 * MiB, WS_WOUT = 113 * MiB, WS_WPG = 121 * MiB, WS_WPP = 129 * MiB;
constexpr size_t WS_H = 130 * MiB;
constexpr size_t WS_OUTA = 130 * MiB, WS_OUTB = 162 * MiB;
constexpr size_t WS_ACT = 194 * MiB;
constexpr size_t WS_Q = 194 * MiB, WS_K = 226 * MiB, WS_V = 234 * MiB, WS_QB = 242 * MiB, WS_IB = 274 * MiB, WS_OG = 306 * MiB;
constexpr size_t WS_GA = 338 * MiB, WS_GB = 402 * MiB, WS_LOGF = 466 * MiB;
constexpr size_t WS_PP = 402 * MiB;
constexpr size_t WS_SS = 530 * MiB;
constexpr size_t WS_BAR = 530 * MiB + 512 * 1024;
constexpr size_t WS_END = 531 * MiB;

typedef float f32x2_t __attribute__((ext_vector_type(2))); typedef __bf16 bf16x2_t __attribute__((ext_vector_type(2)));
__device__ __forceinline__ unsigned cvt_pk_bf16(float lo, float hi) { const f32x2_t v = {lo, hi}; const bf16x2_t b = __builtin_convertvector(v, bf16x2_t); return __builtin_bit_cast(unsigned, b); }
__device__ __forceinline__ bf16_t f2bf(float f) { return (bf16_t)(cvt_pk_bf16(f, 0.f) & 0xffffu); }
__device__ __forceinline__ float bf2f(unsigned b) { return __uint_as_float(b << 16); }
__device__ __forceinline__ float bflo(unsigned w) { return __uint_as_float(w << 16); }
__device__ __forceinline__ float bfhi(unsigned w) { return __uint_as_float(w & 0xffff0000u); }
__device__ __forceinline__ float ex2(float x) { return __builtin_amdgcn_exp2f(x); }
__device__ __forceinline__ float rcpf_(float x) { return __builtin_amdgcn_rcpf(x); }
__device__ __forceinline__ float sigm(float x) { return rcpf_(1.f + ex2(-LOG2E * x)); }
__device__ __forceinline__ float silu(float x) { return x * sigm(x); }
__device__ __forceinline__ float wave_sum(float v) {
#pragma unroll
    for (int o = 1; o < 64; o <<= 1) v += __shfl_xor(v, o);
    return v;
}
template <int CTRL> __device__ __forceinline__ float dppmov(float v) { return __int_as_float(__builtin_amdgcn_update_dpp(0, __float_as_int(v), CTRL, 0xF, 0xF, true)); }
__device__ __forceinline__ float grp16_sum(float v) { v += dppmov<0xB1>(v); v += dppmov<0x4E>(v); v += dppmov<0x124>(v); v += dppmov<0x128>(v); return v; }
__device__ __forceinline__ float grp16_max(float v) { v = fmaxf(v, dppmov<0xB1>(v)); v = fmaxf(v, dppmov<0x4E>(v)); v = fmaxf(v, dppmov<0x124>(v)); v = fmaxf(v, dppmov<0x128>(v)); return v; }
#define MFMA16(a, b, c) __builtin_amdgcn_mfma_f32_16x16x32_bf16((a), (b), (c), 0, 0, 0)

namespace pg8 {
constexpr int BM = 256, BK = 64, HALF = 128, HTB = HALF * BK * 2, STAGE_BYTES = 8 * HTB, NXCD = 8, WGM = 8;
__device__ __forceinline__ int lds_byte(int r, int c) { const int st = (r >> 4) * 2 + (c >> 5), rr = r & 15, cc = c & 31, ob = rr * 64 + cc * 2; return st * 1024 + (ob ^ (((ob >> 9) & 1) << 5)); }
__device__ __forceinline__ void stage_rc(int b, int& R, int& C) { const int st = b / 1024, sb = b % 1024, swz = sb ^ (((sb >> 9) & 1) << 5); R = (st >> 1) * 16 + swz / 64; C = (st & 1) * 32 + (swz % 64) / 2; }
__device__ __forceinline__ int perm32(int rho) { const int n = rho >> 4, i = rho & 15; return 8 * (i >> 2) + 4 * n + (i & 3); }
struct Unit { int pm, pn; };
struct Gemm { const bf16_t* A; const bf16_t* Bt; int M, N, K; };
struct StaticOrder {
    int nM, nN, nwg, G, c, wgm;
    __device__ void init(int M, int N, int G_, int c_, int wgm_ = 8) { nM = M / BM; nN = N / BM; nwg = nM * nN; G = G_; c = c_; wgm = wgm_; }
    __device__ bool next(int i, Unit& u) const {
        const long L = (long)i * G + c; if (L >= nwg) return false;
        int wgid = (int)L; { const int q = nwg / NXCD, r = nwg % NXCD, xcd = wgid % NXCD, off = wgid / NXCD; wgid = (xcd < r ? xcd * (q + 1) : r * (q + 1) + (xcd - r) * q) + off; }
        const int nig = wgm * nN, gid = wgid / nig, fm = gid * wgm, gsz = (nM - fm) < wgm ? (nM - fm) : wgm;
        u.pm = fm + ((wgid % nig) % gsz); u.pn = (wgid % nig) / gsz; return true;
    }
};

#ifndef PG8_SP2
#define PG8_SP2 true
#endif
template <class Epi, bool AT = false, bool BT = false, bool SP2 = PG8_SP2>
__device__ __forceinline__ void gemm_phase(LAS unsigned char* lds, const Gemm g, const StaticOrder& S, const Epi& E) {
    const int tid = threadIdx.x, wid = __builtin_amdgcn_readfirstlane(tid >> 6), lane = tid & 63, wr = wid >> 2, wc = wid & 3, fr = lane & 15, fq = lane >> 4;
    int K = g.K; asm volatile("" : "+s"(K));
    const int nt = K / BK;
    unsigned voffA[2], voffB[2];
#pragma unroll
    for (int i = 0; i < 2; ++i) { int R, C; stage_rc(tid * 16 + i * 8192, R, C); const int Rb = Epi::PERM ? ((R & ~31) + perm32(R & 31)) : R;
        voffA[i] = (unsigned)(R * (AT ? 64 : K) + C) * 2u; voffB[i] = (unsigned)(Rb * (BT ? 64 : K) + C) * 2u; }
    const size_t tstep = (size_t)BM * K * 2;
    const size_t kstepA = AT ? (size_t)BM * BK * 2 : (size_t)(BK * 2), kstepB = BT ? (size_t)BM * BK * 2 : (size_t)(BK * 2);
    const size_t hstepA = AT ? (size_t)HALF * BK * 2 : (size_t)HALF * K * 2, hstepB = BT ? (size_t)HALF * BK * 2 : (size_t)HALF * K * 2;
    const unsigned ldsw = (unsigned)wid * 1024u;
    const int aoff = lds_byte(wr * 64 + fr, fq * 8), boff = lds_byte(wc * 32 + fr, fq * 8);
#define PG8_SA(b, h) (((b) * 2 + (h)) * HTB)
#define PG8_SB(b, h) ((4 + (b) * 2 + (h)) * HTB)
#define PG8_STAGE(bufoff, gbase, voff) do { _Pragma("unroll") for (int _i = 0; _i < 2; ++_i) \
        __builtin_amdgcn_global_load_lds((const unsigned*)((const char*)(gbase) + (voff)[_i]), (LAS unsigned*)(lds + (bufoff) + ldsw + _i * 8192), 16, 0, 0); } while (0)
#define PG8_LDA(dst, b, h) do { _Pragma("unroll") for (int m = 0; m < 4; ++m) _Pragma("unroll") for (int k = 0; k < 2; ++k) dst[m][k] = *(const LAS bf16x8*)(lds + PG8_SA(b, h) + aoff + m * 2048 + k * 1024); } while (0)
#define PG8_LDB(dst, b, h) do { _Pragma("unroll") for (int n = 0; n < 2; ++n) _Pragma("unroll") for (int k = 0; k < 2; ++k) dst[n][k] = *(const LAS bf16x8*)(lds + PG8_SB(b, h) + boff + n * 2048 + k * 1024); } while (0)
#define PG8_MMA(ai, bj, At, Bt) do { __builtin_amdgcn_s_setprio(1); _Pragma("unroll") for (int m = 0; m < 4; ++m) _Pragma("unroll") for (int n = 0; n < 2; ++n) _Pragma("unroll") for (int k = 0; k < 2; ++k) \
        acc[ai][bj][m][n] = __builtin_amdgcn_mfma_f32_16x16x32_bf16(Bt[n][k], At[m][k], acc[ai][bj][m][n], 0, 0, 0); __builtin_amdgcn_s_setprio(0); } while (0)
#define PG8_WAIT_V(n) asm volatile("s_waitcnt vmcnt(" #n ")" ::: "memory")
#define PG8_WAIT_L(n) asm volatile("s_waitcnt lgkmcnt(" #n ")" ::: "memory")
#define PG8_BAR __builtin_amdgcn_s_barrier()
#define PG8_SCHED __builtin_amdgcn_sched_barrier(0)
    Unit cur, nxt; int ui = 0;
    if (!S.next(0, cur)) return;
    f32x4 acc[2][2][4][2];
#pragma unroll
    for (int a = 0; a < 2; ++a)
#pragma unroll
        for (int b = 0; b < 2; ++b)
#pragma unroll
            for (int m = 0; m < 4; ++m)
#pragma unroll
                for (int n = 0; n < 2; ++n) acc[a][b][m][n] = (f32x4){0.f, 0.f, 0.f, 0.f};
    bf16x8 At[4][2], B0[2][2], B1[2][2];
    const char* cA = (const char*)g.A + (size_t)cur.pm * tstep; const char* cB = (const char*)g.Bt + (size_t)cur.pn * tstep;
    if (SP2) { PG8_STAGE(PG8_SB(0, 0), cB, voffB); PG8_STAGE(PG8_SB(0, 1), cB + hstepB, voffB); PG8_STAGE(PG8_SA(0, 0), cA, voffA); PG8_STAGE(PG8_SA(0, 1), cA + hstepA, voffA); }
    else { PG8_STAGE(PG8_SB(0, 0), cB, voffB); PG8_STAGE(PG8_SA(0, 0), cA, voffA); PG8_STAGE(PG8_SB(0, 1), cB + hstepB, voffB); PG8_STAGE(PG8_SA(0, 1), cA + hstepA, voffA); }
    if (wr == 1) PG8_BAR;
    if (SP2) PG8_WAIT_V(2); else PG8_WAIT_V(4);
    PG8_BAR;
    PG8_STAGE(PG8_SB(1, 0), cB + kstepB, voffB); PG8_STAGE(PG8_SA(1, 0), cA + kstepA, voffA); PG8_STAGE(PG8_SB(1, 1), cB + hstepB + kstepB, voffB);
    PG8_WAIT_V(6); PG8_BAR;
    for (;;) {
        const bool has_next = S.next(ui + 1, nxt);
        const char* nA = has_next ? (const char*)g.A + (size_t)nxt.pm * tstep : cA; const char* nB = has_next ? (const char*)g.Bt + (size_t)nxt.pn * tstep : cB;
        for (int t = 0; t < nt; t += 2) {
            const bool last = (t == nt - 2);
            const char* a1 = cA + (size_t)(t + 1) * kstepA;
            const char* a2 = last ? nA : cA + (size_t)(t + 2) * kstepA; const char* b2 = last ? nB : cB + (size_t)(t + 2) * kstepB;
            const char* a3 = a2 + kstepA; const char* b3 = b2 + kstepB;
            if constexpr (SP2) {
            PG8_LDB(B0, 0, 0); PG8_LDB(B1, 0, 1); PG8_SCHED; PG8_LDA(At, 0, 0); PG8_STAGE(PG8_SA(1, 1), a1 + hstepA, voffA);
            PG8_WAIT_V(8); PG8_WAIT_L(0); PG8_BAR; PG8_MMA(0, 0, At, B0); PG8_MMA(0, 1, At, B1); PG8_BAR; PG8_SCHED;
            PG8_LDA(At, 0, 1); PG8_STAGE(PG8_SB(0, 0), b2, voffB); PG8_STAGE(PG8_SB(0, 1), b2 + hstepB, voffB); PG8_STAGE(PG8_SA(0, 0), a2, voffA);
            PG8_WAIT_V(8); PG8_WAIT_L(0); PG8_BAR; PG8_MMA(1, 0, At, B0); PG8_MMA(1, 1, At, B1); PG8_BAR; PG8_SCHED;
            PG8_LDB(B0, 1, 0); PG8_LDB(B1, 1, 1); PG8_SCHED; PG8_LDA(At, 1, 0); PG8_STAGE(PG8_SA(0, 1), a2 + hstepA, voffA);
            PG8_WAIT_V(8); PG8_WAIT_L(0); PG8_BAR; PG8_MMA(0, 0, At, B0); PG8_MMA(0, 1, At, B1); PG8_BAR; PG8_SCHED;
            PG8_LDA(At, 1, 1); PG8_STAGE(PG8_SB(1, 0), b3, voffB); PG8_STAGE(PG8_SB(1, 1), b3 + hstepB, voffB); PG8_STAGE(PG8_SA(1, 0), a3, voffA);
            PG8_WAIT_V(8); PG8_WAIT_L(0); PG8_BAR; PG8_MMA(1, 0, At, B0); PG8_MMA(1, 1, At, B1); PG8_BAR; PG8_SCHED;
            } else {
            PG8_LDB(B0, 0, 0); PG8_SCHED; PG8_LDA(At, 0, 0); PG8_STAGE(PG8_SA(1, 1), a1 + hstepA, voffA);
            PG8_WAIT_L(8); PG8_BAR; PG8_WAIT_L(0); PG8_MMA(0, 0, At, B0); PG8_BAR; PG8_SCHED;
            PG8_LDB(B1, 0, 1); PG8_STAGE(PG8_SB(0, 0), b2, voffB);
            PG8_BAR; PG8_WAIT_L(0); PG8_MMA(0, 1, At, B1); PG8_BAR;
            PG8_LDA(At, 0, 1); PG8_STAGE(PG8_SA(0, 0), a2, voffA);
            PG8_BAR; PG8_WAIT_L(0); PG8_MMA(1, 0, At, B0); PG8_BAR; PG8_SCHED;
            PG8_STAGE(PG8_SB(0, 1), b2 + hstepB, voffB);
            PG8_WAIT_V(6); PG8_BAR; PG8_MMA(1, 1, At, B1); PG8_BAR;
            PG8_LDB(B0, 1, 0); PG8_SCHED; PG8_LDA(At, 1, 0); PG8_STAGE(PG8_SA(0, 1), a2 + hstepA, voffA);
            PG8_WAIT_L(8); PG8_BAR; PG8_WAIT_L(0); PG8_MMA(0, 0, At, B0); PG8_BAR; PG8_SCHED;
            PG8_LDB(B1, 1, 1); PG8_STAGE(PG8_SB(1, 0), b3, voffB);
            PG8_BAR; PG8_WAIT_L(0); PG8_MMA(0, 1, At, B1); PG8_BAR;
            PG8_LDA(At, 1, 1); PG8_STAGE(PG8_SA(1, 0), a3, voffA);
            PG8_BAR; PG8_WAIT_L(0); PG8_MMA(1, 0, At, B0); PG8_BAR; PG8_SCHED;
            PG8_STAGE(PG8_SB(1, 1), b3 + hstepB, voffB);
            PG8_WAIT_V(6); PG8_BAR; PG8_MMA(1, 1, At, B1); PG8_BAR;
            }
        }
        if (wr == 0) PG8_BAR;
        E(acc, cur, wr, wc, fr, fq);
        if (!has_next) break;
#pragma unroll
        for (int a = 0; a < 2; ++a)
#pragma unroll
            for (int b = 0; b < 2; ++b)
#pragma unroll
                for (int m = 0; m < 4; ++m)
#pragma unroll
                    for (int n = 0; n < 2; ++n) acc[a][b][m][n] = (f32x4){0.f, 0.f, 0.f, 0.f};
        cur = nxt; cA = nA; cB = nB; ++ui;
        if (wr == 1) PG8_BAR;
    }
    PG8_WAIT_V(0);
    PG8_BAR;
#undef PG8_SA
#undef PG8_SB
#undef PG8_STAGE
#undef PG8_LDA
#undef PG8_LDB
#undef PG8_MMA
#undef PG8_WAIT_V
#undef PG8_WAIT_L
#undef PG8_BAR
#undef PG8_SCHED
}
}
using pg8::Unit;

__device__ __forceinline__ u32x4 pack8(const f32x4 a, const f32x4 b) { u32x4 w; w.x = cvt_pk_bf16(a[0], a[1]); w.y = cvt_pk_bf16(a[2], a[3]); w.z = cvt_pk_bf16(b[0], b[1]); w.w = cvt_pk_bf16(b[2], b[3]); return w; }
__device__ __forceinline__ void unpack8(const u32x4 w, f32x4& a, f32x4& b) { a = (f32x4){bflo(w.x), bfhi(w.x), bflo(w.y), bfhi(w.y)}; b = (f32x4){bflo(w.z), bfhi(w.z), bflo(w.w), bfhi(w.w)}; }

struct EpiSwiGLU {
    static constexpr bool PERM = true;
    bf16_t* O; const float* ss;
    __device__ __forceinline__ void operator()(const f32x4 (&acc)[2][2][4][2], const Unit& u, int wr, int wc, int fr, int fq) const {
        const int rl0 = wr * 64 + fr, kt = u.pn * 2 + (wc >> 1), within = (wc & 1) * 32 + 8 * fq;
        float rsv[2][4];
#pragma unroll
        for (int ai = 0; ai < 2; ++ai)
#pragma unroll
            for (int m = 0; m < 4; ++m) rsv[ai][m] = ss ? ss[u.pm * 256 + rl0 + ai * 128 + m * 16] : 0.f;
#pragma unroll
        for (int ai = 0; ai < 2; ++ai)
#pragma unroll
            for (int m = 0; m < 4; ++m) {
                const float rs = ss ? 1.0f / sqrtf(rsv[ai][m] * (1.f / DM) + EPS) : 1.f;
                f32x4 v0, v1;
#pragma unroll
                for (int j = 0; j < 4; ++j) { v0[j] = silu(acc[ai][0][m][0][j] * rs) * (acc[ai][1][m][0][j] * rs); v1[j] = silu(acc[ai][0][m][1][j] * rs) * (acc[ai][1][m][1][j] * rs); }
                *(u32x4*)(O + ((size_t)u.pm * (FF / 64) + kt) * 16384 + (size_t)(rl0 + ai * 128 + m * 16) * 64 + within) = pack8(v0, v1);
            }
    }
};
struct EpiResid {
    static constexpr bool PERM = false;
    const float* base; float* out; float scale;
    __device__ __forceinline__ void operator()(const f32x4 (&acc)[2][2][4][2], const Unit& u, int wr, int wc, int fr, int fq) const {
        const int row0 = u.pm * 256 + wr * 64 + fr, col0 = u.pn * 256 + wc * 32 + 4 * fq;
#pragma unroll
        for (int ai = 0; ai < 2; ++ai)
#pragma unroll
            for (int m = 0; m < 4; ++m) { const size_t off = (size_t)(row0 + ai * 128 + m * 16) * DM + col0;
#pragma unroll
                for (int bj = 0; bj < 2; ++bj)
#pragma unroll
                    for (int n = 0; n < 2; ++n) { const f32x4 b = *(const f32x4*)(base + off + bj * 128 + n * 16); *(f32x4*)(out + off + bj * 128 + n * 16) = b + scale * acc[ai][bj][m][n]; }
                asm volatile("" ::: "memory"); }
    }
};
struct EpiResidNorm {
    static constexpr bool PERM = false;
    const float* base; float* out; float scale; const float* nw; bf16_t* hb; float* ss;
    __device__ __forceinline__ void operator()(const f32x4 (&acc)[2][2][4][2], const Unit& u, int wr, int wc, int fr, int fq) const {
        const int row0 = u.pm * 256 + wr * 64 + fr, col0 = u.pn * 256 + wc * 32 + 4 * fq;
        f32x4 wv[2][2];
#pragma unroll
        for (int bj = 0; bj < 2; ++bj)
#pragma unroll
            for (int n = 0; n < 2; ++n) wv[bj][n] = *(const f32x4*)(nw + col0 + bj * 128 + n * 16);
        f32x4 pre[3][2][2];
#define ERN_LOAD(g, slot) do { _Pragma("unroll") for (int bj = 0; bj < 2; ++bj) _Pragma("unroll") for (int n = 0; n < 2; ++n) \
        pre[slot][bj][n] = *(const f32x4*)(base + (size_t)(row0 + ((g) >> 2) * 128 + ((g) & 3) * 16) * DM + col0 + bj * 128 + n * 16); } while (0)
        ERN_LOAD(0, 0); ERN_LOAD(1, 1);
#pragma unroll
        for (int g = 0; g < 8; ++g) { const int ai = g >> 2, m = g & 3, slot = g % 3;
            if (g < 6) { if ((g + 2) % 3 == 0) ERN_LOAD(g + 2, 0); else if ((g + 2) % 3 == 1) ERN_LOAD(g + 2, 1); else ERN_LOAD(g + 2, 2); }
            { const int row = row0 + ai * 128 + m * 16; const size_t off = (size_t)row * DM + col0; float s = 0.f;
#pragma unroll
                for (int bj = 0; bj < 2; ++bj)
#pragma unroll
                    for (int n = 0; n < 2; ++n) { const size_t o = off + bj * 128 + n * 16; const f32x4 r = pre[slot][bj][n] + scale * acc[ai][bj][m][n]; *(f32x4*)(out + o) = r;
                        s += (r[0] * r[0] + r[1] * r[1]) + (r[2] * r[2] + r[3] * r[3]); const f32x4 hv = r * wv[bj][n];
                        u32x2 hw; hw.x = cvt_pk_bf16(hv[0], hv[1]); hw.y = cvt_pk_bf16(hv[2], hv[3]); *(u32x2*)(hb + o) = hw; }
                s += __shfl_xor(s, 16); s += __shfl_xor(s, 32);
                if (fq == 0) __hip_atomic_fetch_add(ss + row, s, __ATOMIC_RELAXED, __HIP_MEMORY_SCOPE_AGENT); }
            asm volatile("" ::: "memory"); }
#undef ERN_LOAD
    }
};
struct EpiPle {
    static constexpr bool PERM = false;
    const float* base; float* out; const bf16_t* pp; const float* ss;
    __device__ __forceinline__ void operator()(const f32x4 (&acc)[2][2][4][2], const Unit& u, int wr, int wc, int fr, int fq) const {
        const int row0 = u.pm * 256 + wr * 64 + fr, col0 = u.pn * 256 + wc * 32 + 4 * fq;
        float rsv[2][4];
#pragma unroll
        for (int ai = 0; ai < 2; ++ai)
#pragma unroll
            for (int m = 0; m < 4; ++m) rsv[ai][m] = ss[row0 + ai * 128 + m * 16];
        f32x4 pb[2][2][2]; u32x2 pw[2][2][2];
#define EPL_LOAD(g, slot) do { _Pragma("unroll") for (int bj = 0; bj < 2; ++bj) _Pragma("unroll") for (int n = 0; n < 2; ++n) { \
        const size_t o_ = (size_t)(row0 + ((g) >> 2) * 128 + ((g) & 3) * 16) * DM + col0 + bj * 128 + n * 16; pb[slot][bj][n] = *(const f32x4*)(base + o_); pw[slot][bj][n] = *(const u32x2*)(pp + o_); } } while (0)
        EPL_LOAD(0, 0);
#pragma unroll
        for (int g = 0; g < 8; ++g) { const int ai = g >> 2, m = g & 3, slot = g & 1;
            if (g < 7) { if (slot == 0) EPL_LOAD(g + 1, 1); else EPL_LOAD(g + 1, 0); }
            const float rs = 1.0f / sqrtf(rsv[ai][m] * (1.f / DM) + EPS);
#pragma unroll
            for (int bj = 0; bj < 2; ++bj)
#pragma unroll
                for (int n = 0; n < 2; ++n) { const size_t o = (size_t)(row0 + ai * 128 + m * 16) * DM + col0 + bj * 128 + n * 16; const u32x2 w2 = pw[slot][bj][n];
                    const f32x4 pv = (f32x4){bflo(w2.x), bfhi(w2.x), bflo(w2.y), bfhi(w2.y)}; f32x4 r;
#pragma unroll
                    for (int j = 0; j < 4; ++j) r[j] = pb[slot][bj][n][j] + sigm(acc[ai][bj][m][n][j] * rs) * pv[j];
                    *(f32x4*)(out + o) = r; }
            asm volatile("" ::: "memory"); }
#undef EPL_LOAD
    }
};
struct EpiPleFinal {
    static constexpr bool PERM = false;
    const float* base; float* out; const bf16_t* pp; const float* ss; float* ss3; unsigned* cnt; const float* fw;
    __device__ __forceinline__ void operator()(f32x4 (&acc)[2][2][4][2], const Unit& u, int wr, int wc, int fr, int fq) const {
        const int row0 = u.pm * 256 + wr * 64 + fr, col0 = u.pn * 256 + wc * 32 + 4 * fq;
        float rsv[2][4];
#pragma unroll
        for (int ai = 0; ai < 2; ++ai)
#pragma unroll
            for (int m = 0; m < 4; ++m) rsv[ai][m] = ss[row0 + ai * 128 + m * 16];
        f32x4 pb[2][2][2]; u32x2 pw[2][2][2];
#define EPF_LOAD(g, slot) do { _Pragma("unroll") for (int bj = 0; bj < 2; ++bj) _Pragma("unroll") for (int n = 0; n < 2; ++n) { \
        const size_t o_ = (size_t)(row0 + ((g) >> 2) * 128 + ((g) & 3) * 16) * DM + col0 + bj * 128 + n * 16; pb[slot][bj][n] = *(const f32x4*)(base + o_); pw[slot][bj][n] = *(const u32x2*)(pp + o_); } } while (0)
        EPF_LOAD(0, 0);
#pragma unroll
        for (int g = 0; g < 8; ++g) { const int ai = g >> 2, m = g & 3, slot = g & 1;
            if (g < 7) { if (slot == 0) EPF_LOAD(g + 1, 1); else EPF_LOAD(g + 1, 0); }
            const float rs = 1.0f / sqrtf(rsv[ai][m] * (1.f / DM) + EPS); float s = 0.f;
#pragma unroll
            for (int bj = 0; bj < 2; ++bj)
#pragma unroll
                for (int n = 0; n < 2; ++n) { const u32x2 w2 = pw[slot][bj][n]; const f32x4 pv = (f32x4){bflo(w2.x), bfhi(w2.x), bflo(w2.y), bfhi(w2.y)}; f32x4 r;
#pragma unroll
                    for (int j = 0; j < 4; ++j) r[j] = pb[slot][bj][n][j] + sigm(acc[ai][bj][m][n][j] * rs) * pv[j];
                    acc[ai][bj][m][n] = r; s += (r[0] * r[0] + r[1] * r[1]) + (r[2] * r[2] + r[3] * r[3]); }
            s += __shfl_xor(s, 16); s += __shfl_xor(s, 32);
            if (fq == 0) __hip_atomic_fetch_add(ss3 + row0 + ai * 128 + m * 16, s, __ATOMIC_RELAXED, __HIP_MEMORY_SCOPE_AGENT); }
#undef EPF_LOAD
        asm volatile("s_waitcnt vmcnt(0) lgkmcnt(0)" ::: "memory"); __builtin_amdgcn_s_barrier(); asm volatile("" ::: "memory");
        if (threadIdx.x == 0) { unsigned* c = cnt + 8 * u.pm; (void)__hip_atomic_fetch_add(c, 1u, __ATOMIC_RELAXED, __HIP_MEMORY_SCOPE_AGENT); unsigned sp = 0u;
            while (__hip_atomic_load(c, __ATOMIC_RELAXED, __HIP_MEMORY_SCOPE_AGENT) < 8u && ++sp < 100000u) __builtin_amdgcn_s_sleep(2);
            __builtin_amdgcn_fence(__ATOMIC_ACQUIRE, "agent"); asm volatile("s_waitcnt vmcnt(0)" ::: "memory"); }
        __builtin_amdgcn_s_barrier(); asm volatile("" ::: "memory");
        f32x4 fwv[2][2];
#pragma unroll
        for (int bj = 0; bj < 2; ++bj)
#pragma unroll
            for (int n = 0; n < 2; ++n) fwv[bj][n] = *(const f32x4*)(fw + col0 + bj * 128 + n * 16);
        float tot[2][4];
#pragma unroll
        for (int ai = 0; ai < 2; ++ai)
#pragma unroll
            for (int m = 0; m < 4; ++m) tot[ai][m] = __hip_atomic_load(ss3 + row0 + ai * 128 + m * 16, __ATOMIC_RELAXED, __HIP_MEMORY_SCOPE_AGENT);
#pragma unroll
        for (int ai = 0; ai < 2; ++ai)
#pragma unroll
            for (int m = 0; m < 4; ++m) { const float rstd = 1.0f / sqrtf(tot[ai][m] * (1.f / DM) + EPS); const size_t off = (size_t)(row0 + ai * 128 + m * 16) * DM + col0;
#pragma unroll
                for (int bj = 0; bj < 2; ++bj)
#pragma unroll
                    for (int n = 0; n < 2; ++n) *(f32x4*)(out + off + bj * 128 + n * 16) = acc[ai][bj][m][n] * rstd * fwv[bj][n]; }
    }
};
template <int MODE> struct EpiBf {
    static constexpr bool PERM = true;
    bf16_t* O; const bf16_t* X;
    __device__ __forceinline__ void operator()(const f32x4 (&acc)[2][2][4][2], const Unit& u, int wr, int wc, int fr, int fq) const {
        const int row0 = u.pm * 256 + wr * 64 + fr, col0 = u.pn * 256 + wc * 32 + 8 * fq;
#pragma unroll
        for (int ai = 0; ai < 2; ++ai) {
            u32x4 po[4][2], px[4][2];
            if (MODE >= 1) {
#pragma unroll
                for (int m = 0; m < 4; ++m)
#pragma unroll
                    for (int bj = 0; bj < 2; ++bj) { const size_t o = (size_t)(row0 + ai * 128 + m * 16) * DM + col0 + bj * 128; po[m][bj] = *(const u32x4*)(O + o); if (MODE == 2) px[m][bj] = *(const u32x4*)(X + o); } }
#pragma unroll
            for (int m = 0; m < 4; ++m)
#pragma unroll
                for (int bj = 0; bj < 2; ++bj) { const size_t o = (size_t)(row0 + ai * 128 + m * 16) * DM + col0 + bj * 128;
                    f32x4 v0 = acc[ai][bj][m][0], v1 = acc[ai][bj][m][1];
                    if (MODE >= 1) { f32x4 g0, g1; unpack8(po[m][bj], g0, g1); v0 = v0 * g0; v1 = v1 * g1; }
                    if (MODE == 2) { f32x4 x0, x1; unpack8(px[m][bj], x0, x1); v0 = v0 + x0; v1 = v1 + x1; }
                    *(u32x4*)(O + o) = pack8(v0, v1); }
            asm volatile("" ::: "memory"); }
    }
};
struct EpiProj {
    static constexpr bool PERM = true;
    bf16_t *Q, *Kk, *V, *QB, *IB, *OG, *GA, *GB; float* LOGF; const float* ropec; const float* ropes; const float* lbp; const float* ss;
    __device__ __forceinline__ void operator()(const f32x4 (&acc)[2][2][4][2], const Unit& u, int wr, int wc, int fr, int fq) const {
        const int pn = u.pn, row0 = u.pm * 256 + wr * 64 + fr, cw = wc * 32 + 8 * fq;
        float rs[2][4];
#pragma unroll
        for (int ai = 0; ai < 2; ++ai)
#pragma unroll
            for (int m = 0; m < 4; ++m) rs[ai][m] = 1.0f / sqrtf(ss[row0 + ai * 128 + m * 16] * (1.f / DM) + EPS);
        if (pn < 5) {
            bf16_t* base = pn < 4 ? Q : Kk; const int ld = pn < 4 ? 1024 : 256, colt = pn < 4 ? pn * 256 : 0; const float sc = pn < 4 ? QSCALE : 1.f;
            const bool ropew = ((wc & 1) == 0) && (fq < 2);
#pragma unroll
            for (int ai = 0; ai < 2; ++ai)
#pragma unroll
              for (int mh = 0; mh < 2; ++mh) {
                f32x4 rc0[2], rc1[2], rs0[2], rs1[2];
#pragma unroll
                for (int ml = 0; ml < 2; ++ml) { const size_t rr = (size_t)(row0 + ai * 128 + (2 * mh + ml) * 16) * 8;
                    rc0[ml] = (f32x4){1.f, 1.f, 1.f, 1.f}; rc1[ml] = rc0[ml]; rs0[ml] = (f32x4){0.f, 0.f, 0.f, 0.f}; rs1[ml] = rs0[ml];
                    if (ropew) { rc0[ml] = *(const f32x4*)(ropec + rr); rc1[ml] = *(const f32x4*)(ropec + rr + 4); rs0[ml] = *(const f32x4*)(ropes + rr); rs1[ml] = *(const f32x4*)(ropes + rr + 4); } }
#pragma unroll
                for (int ml = 0; ml < 2; ++ml) { const int m = 2 * mh + ml; const int row = row0 + ai * 128 + m * 16;
                    f32x4 c0 = rc0[ml], c1 = rc1[ml], s0 = rs0[ml], s1 = rs1[ml];
                    if (ropew && fq == 0) { s0 = -s0; s1 = -s1; }
#pragma unroll
                    for (int bj = 0; bj < 2; ++bj) { f32x4 v0 = acc[ai][bj][m][0] * rs[ai][m], v1 = acc[ai][bj][m][1] * rs[ai][m], p0, p1;
#pragma unroll
                        for (int j = 0; j < 4; ++j) { p0[j] = __shfl_xor(v0[j], 16); p1[j] = __shfl_xor(v1[j], 16); }
                        v0 = (v0 * c0 + p0 * s0) * sc; v1 = (v1 * c1 + p1 * s1) * sc;
                        *(u32x4*)(base + (size_t)row * ld + colt + bj * 128 + cw) = pack8(v0, v1); } }
                asm volatile("" ::: "memory"); }
        } else if (pn >= 10 && pn < 14) {
            const int colt = (pn - 10) * 256;
            f32x4 lb[2][2];
#pragma unroll
            for (int bj = 0; bj < 2; ++bj)
#pragma unroll
                for (int n = 0; n < 2; ++n) { const int c = colt + bj * 128 + cw + 4 * n; const f32x4 a0 = *(const f32x4*)(lbp + c), a1 = *(const f32x4*)(lbp + 1024 + c);
#pragma unroll
                    for (int j = 0; j < 4; ++j) lb[bj][n][j] = rcpf_(1.f + ex2(LOG2E * (a1[j] - a0[j]))); }
#pragma unroll
            for (int ai = 0; ai < 2; ++ai)
#pragma unroll
                for (int m = 0; m < 4; ++m) { const int row = row0 + ai * 128 + m * 16;
#pragma unroll
                    for (int bj = 0; bj < 2; ++bj)
#pragma unroll
                        for (int n = 0; n < 2; ++n) { f32x4 r;
#pragma unroll
                            for (int j = 0; j < 4; ++j) { const float l = lb[bj][n][j]; r[j] = __builtin_amdgcn_logf(l + (1.f - l) * sigm(acc[ai][bj][m][n][j] * rs[ai][m])); }
                            *(f32x4*)(LOGF + (size_t)row * 1024 + colt + bj * 128 + cw + 4 * n) = r; }
                    asm volatile("" ::: "memory"); }
        } else {
            bf16_t* base; int ld, colt, act;
            if (pn == 5) { base = V; ld = 256; colt = 0; act = 0; }
            else if (pn < 10) { base = QB; ld = 1024; colt = (pn - 6) * 256; act = 1; }
            else if (pn < 18) { base = IB; ld = 1024; colt = (pn - 14) * 256; act = 0; }
            else if (pn < 22) { base = OG; ld = 1024; colt = (pn - 18) * 256; act = 1; }
            else if (pn < 30) { base = GA; ld = 2048; colt = (pn - 22) * 256; act = 2; }
            else { base = GB; ld = 2048; colt = (pn - 30) * 256; act = 2; }
#pragma unroll
            for (int ai = 0; ai < 2; ++ai)
#pragma unroll
                for (int m = 0; m < 4; ++m) { const int row = row0 + ai * 128 + m * 16;
#pragma unroll
                    for (int bj = 0; bj < 2; ++bj) { f32x4 v0 = acc[ai][bj][m][0] * rs[ai][m], v1 = acc[ai][bj][m][1] * rs[ai][m];
                        if (act != 0) {
#pragma unroll
                            for (int j = 0; j < 4; ++j) { const float g0 = sigm(v0[j]), g1 = sigm(v1[j]); v0[j] = act == 1 ? v0[j] * g0 : g0; v1[j] = act == 1 ? v1[j] * g1 : g1; } }
                        *(u32x4*)(base + (size_t)row * ld + colt + bj * 128 + cw) = pack8(v0, v1); }
                    asm volatile("" ::: "memory"); }
        }
    }
};

struct Args { const void* in[23]; float* out; unsigned char* ws; int ph_lo, ph_hi; };

struct Ctx { LAS unsigned char* lds; int tid, lane, wave, G, bid; };

__device__ __forceinline__ void conv_matrix(const Ctx& C, const float* W, int K, int N, bf16_t* WT, int blk, int stride, int off, bool tiled = false) {
    LAS float* scr = (LAS float*)(C.lds + C.wave * 16384);
    const int gw = C.bid * NWAVES + C.wave, NGW = C.G * NWAVES, nblk = N / 32, nitems = (K / 64) * nblk, lane = C.lane;
    for (int item = gw; item < nitems; item += NGW) {
        const int kb = item / nblk, nb = item % nblk, k0 = 64 * kb, n0 = 32 * nb;
        float wv_[32];
#pragma unroll
        for (int i = 0; i < 32; ++i) wv_[i] = __builtin_nontemporal_load(W + (size_t)(k0 + 2 * i + (lane >> 5)) * N + n0 + (lane & 31));
#pragma unroll
        for (int i = 0; i < 32; ++i) scr[(2 * i + (lane >> 5)) * 33 + (lane & 31)] = wv_[i];
        asm volatile("s_waitcnt lgkmcnt(0)" ::: "memory");
        const int c = lane & 7;
#pragma unroll
        for (int j = 0; j < 4; ++j) { const int n = (lane >> 3) + 8 * j; const LAS float* s = scr + (8 * c) * 33 + n;
            u32x4 o; o.x = cvt_pk_bf16(s[0 * 33], s[1 * 33]); o.y = cvt_pk_bf16(s[2 * 33], s[3 * 33]); o.z = cvt_pk_bf16(s[4 * 33], s[5 * 33]); o.w = cvt_pk_bf16(s[6 * 33], s[7 * 33]);
            const int ng = n0 + n, drow = (ng / blk) * stride + off + (ng % blk);
            const size_t dst = tiled ? ((size_t)(drow >> 8) * (K >> 6) + (k0 >> 6)) * 16384 + (size_t)(drow & 255) * 64 + 8 * c : (size_t)drow * K + k0 + 8 * c;
            *(u32x4*)(WT + dst) = o; }
        asm volatile("s_waitcnt lgkmcnt(0)" ::: "memory");
    }
}
__device__ __forceinline__ void norm_rows_bf16(const Ctx& C, const float* X, const float* w, bf16_t* O) {
    const int gw = C.bid * NWAVES + C.wave, NGW = C.G * NWAVES, lane = C.lane;
    f32x4 wv[8];
#pragma unroll
    for (int j = 0; j < 8; ++j) wv[j] = *(const f32x4*)(w + 4 * lane + 256 * j);
    for (int m = gw; m < T; m += NGW) {
        const float* xr = X + (size_t)m * DM + 4 * lane; f32x4 v[8]; float s = 0.f;
#pragma unroll
        for (int j = 0; j < 8; ++j) { v[j] = *(const f32x4*)(xr + 256 * j); s += (v[j][0] * v[j][0] + v[j][1] * v[j][1]) + (v[j][2] * v[j][2] + v[j][3] * v[j][3]); }
        const float rstd = 1.0f / sqrtf(wave_sum(s) * (1.f / DM) + EPS);
        bf16_t* orow = O + (size_t)m * DM + 4 * lane;
#pragma unroll
        for (int j = 0; j < 8; ++j) { const f32x4 r = v[j] * rstd * wv[j]; u32x2 o; o.x = cvt_pk_bf16(r[0], r[1]); o.y = cvt_pk_bf16(r[2], r[3]); *(u32x2*)(orow + 256 * j) = o; }
    }
}
__device__ __forceinline__ void norm_rows_f32_inplace(const Ctx& C, float* X, const float* w) {
    const int gw = C.bid * NWAVES + C.wave, NGW = C.G * NWAVES, lane = C.lane;
    f32x4 wv[8];
#pragma unroll
    for (int j = 0; j < 8; ++j) wv[j] = *(const f32x4*)(w + 4 * lane + 256 * j);
    for (int m = gw; m < T; m += NGW) {
        float* xr = X + (size_t)m * DM + 4 * lane; f32x4 v[8]; float s = 0.f;
#pragma unroll
        for (int j = 0; j < 8; ++j) { v[j] = *(const f32x4*)(xr + 256 * j); s += (v[j][0] * v[j][0] + v[j][1] * v[j][1]) + (v[j][2] * v[j][2] + v[j][3] * v[j][3]); }
        const float rstd = 1.0f / sqrtf(wave_sum(s) * (1.f / DM) + EPS);
#pragma unroll
        for (int j = 0; j < 8; ++j) *(f32x4*)(xr + 256 * j) = v[j] * rstd * wv[j];
    }
}
__device__ __forceinline__ void rope_tables(const Ctx& C, const int* positions, float* rc, float* rs) {
    const float invf[8] = {1.0f, 0.1939227432012558f, 0.03760603070259094f, 0.007292664609849453f, 0.0014142135623842478f, 0.00027424818836152554f, 5.318296098266728e-05f, 1.0313386155758053e-05f};
    for (int idx = C.bid * NTHREADS + C.tid; idx < T * 8; idx += C.G * NTHREADS) {
        const int t = idx >> 3, i = idx & 7;
        float f = invf[0];
#pragma unroll
        for (int k = 1; k < 8; ++k) f = (i == k) ? invf[k] : f;
        const float ang = (float)positions[t] * f;
        double rev = (double)ang * 0.15915494309189535; rev -= __builtin_rint(rev);
        const float r = (float)rev;
        rc[idx] = __builtin_amdgcn_cosf(r); rs[idx] = __builtin_amdgcn_sinf(r);
    }
}
__device__ __forceinline__ void conv_p(const Ctx& C, const float* p, bf16_t* pb) {
    for (size_t i = (size_t)(C.bid * NTHREADS + C.tid) * 8; i < (size_t)T * PLE; i += (size_t)C.G * NTHREADS * 8) {
        const f32x4 a = *(const f32x4*)(p + i), b = *(const f32x4*)(p + i + 4); *(u32x4*)(pb + i) = pack8(a, b); }
}

__device__ __forceinline__ void attn_phase(const Ctx& C, const bf16_t* Q, const bf16_t* K, const bf16_t* V, const float* sinks, bf16_t* O) {
    const int tid = C.tid, lane = C.lane, w = C.wave, fr = lane & 15, fq = lane >> 4;
    LAS bf16_t* Ks = (LAS bf16_t*)C.lds;
    LAS bf16_t* Vt = (LAS bf16_t*)(C.lds + 36864);
    LAS bf16_t* Pw = (LAS bf16_t*)(C.lds + 36864 + 33792 + w * 8448);
    for (int unit = C.bid; unit < 512; unit += C.G) {
        const int n = unit & 31, kvh = (unit >> 5) & 3, b = unit >> 7;
        u32x4 kq[4], vq[4];
#pragma unroll
        for (int i = 0; i < 4; ++i) { const int ch = tid + 512 * i, j = ch >> 3, c8 = (ch & 7) * 8, pos = (n - 1) * 128 + j, posc = pos < 0 ? 0 : pos;
            const size_t g = ((size_t)(b * SEQ + posc)) * 256 + kvh * 64 + c8; kq[i] = *(const u32x4*)(K + g); vq[i] = *(const u32x4*)(V + g); }
        bf16x8 qfa[4][2]; float sk[4];
#pragma unroll
        for (int g = 0; g < 4; ++g) { const bf16_t* qp = Q + (size_t)(b * SEQ + n * 128 + 16 * w + fr) * 1024 + (kvh * 4 + g) * 64 + 8 * fq;
            qfa[g][0] = *(const bf16x8*)qp; qfa[g][1] = *(const bf16x8*)(qp + 32); sk[g] = sinks[kvh * 4 + g]; }
        __syncthreads();
#pragma unroll
        for (int i = 0; i < 4; ++i) {
            const int ch = tid + 512 * i, j = ch >> 3, c8 = (ch & 7) * 8, pos = (n - 1) * 128 + j;
            u32x4 kv = kq[i], vv = vq[i];
            if (pos < 0) { kv = (u32x4){0u, 0u, 0u, 0u}; vv = kv; }
            *(LAS u32x4*)(Ks + j * 72 + c8) = kv;
            Vt[(c8 + 0) * 264 + j] = (bf16_t)(vv.x & 0xffffu); Vt[(c8 + 1) * 264 + j] = (bf16_t)(vv.x >> 16);
            Vt[(c8 + 2) * 264 + j] = (bf16_t)(vv.y & 0xffffu); Vt[(c8 + 3) * 264 + j] = (bf16_t)(vv.y >> 16);
            Vt[(c8 + 4) * 264 + j] = (bf16_t)(vv.z & 0xffffu); Vt[(c8 + 5) * 264 + j] = (bf16_t)(vv.z >> 16);
            Vt[(c8 + 6) * 264 + j] = (bf16_t)(vv.w & 0xffffu); Vt[(c8 + 7) * 264 + j] = (bf16_t)(vv.w >> 16);
        }
        __syncthreads();
        const int t0 = w & ~1;
#pragma unroll
        for (int g = 0; g < 4; ++g) {
            const int head = kvh * 4 + g;
            const bf16x8 qf0 = qfa[g][0], qf1 = qfa[g][1];
            f32x4 s[10];
            {
                bf16x8 kf[10][2];
#pragma unroll
                for (int i = 0; i < 10; ++i) { const LAS bf16_t* kp = Ks + (16 * (t0 + i) + fr) * 72 + 8 * fq; kf[i][0] = *(const LAS bf16x8*)kp; kf[i][1] = *(const LAS bf16x8*)(kp + 32); }
                __builtin_amdgcn_sched_barrier(0);
#pragma unroll
                for (int i = 0; i < 10; ++i) { f32x4 a = {0.f, 0.f, 0.f, 0.f}; a = MFMA16(qf0, kf[i][0], a); a = MFMA16(qf1, kf[i][1], a); s[i] = a; }
            }
            const float sink2 = sk[g] * LOG2E;
            float mx[4] = {sink2, sink2, sink2, sink2};
#pragma unroll
            for (int i = 0; i < 10; ++i)
#pragma unroll
                for (int r = 0; r < 4; ++r) { const int j = 16 * (t0 + i) + fr, dist = 16 * w + 4 * fq + r + 128 - j;
                    const bool ok = (dist >= 0) && (dist < 128) && (n > 0 || j >= 128);
                    const float v = ok ? s[i][r] : -INFINITY; s[i][r] = v; mx[r] = fmaxf(mx[r], v); if (r == 3) __builtin_amdgcn_sched_barrier(0); }
            float sum[4], inv[4];
#pragma unroll
            for (int r = 0; r < 4; ++r) { mx[r] = grp16_max(mx[r]); sum[r] = 0.f; }
#pragma unroll
            for (int i = 0; i < 10; ++i)
#pragma unroll
                for (int r = 0; r < 4; ++r) { const float e = ex2(s[i][r] - mx[r]); s[i][r] = e; sum[r] += e; }
#pragma unroll
            for (int r = 0; r < 4; ++r) { sum[r] = grp16_sum(sum[r]) + ex2(sink2 - mx[r]); inv[r] = 1.0f / sum[r]; }
#pragma unroll
            for (int i = 0; i < 10; ++i)
#pragma unroll
                for (int r = 0; r < 4; ++r) Pw[(4 * fq + r) * 264 + 16 * (t0 + i) + fr] = f2bf(s[i][r] * inv[r]);
            asm volatile("s_waitcnt lgkmcnt(0)" ::: "memory");
            f32x4 o[4];
#pragma unroll
            for (int dt = 0; dt < 4; ++dt) o[dt] = (f32x4){0.f, 0.f, 0.f, 0.f};
            {
                bf16x8 pa[5], vf[5][4];
#pragma unroll
                for (int ks = 0; ks < 5; ++ks) { pa[ks] = *(const LAS bf16x8*)(Pw + fr * 264 + 16 * t0 + 32 * ks + 8 * fq);
#pragma unroll
                    for (int dt = 0; dt < 4; ++dt) vf[ks][dt] = *(const LAS bf16x8*)(Vt + (16 * dt + fr) * 264 + 16 * t0 + 32 * ks + 8 * fq); }
                __builtin_amdgcn_sched_barrier(0);
#pragma unroll
                for (int ks = 0; ks < 5; ++ks)
#pragma unroll
                    for (int dt = 0; dt < 4; ++dt) o[dt] = MFMA16(pa[ks], vf[ks][dt], o[dt]);
            }
#pragma unroll
            for (int dt = 0; dt < 4; ++dt)
#pragma unroll
                for (int r = 0; r < 4; ++r) Pw[(4 * fq + r) * 264 + 16 * dt + fr] = f2bf(o[dt][r]);
            asm volatile("s_waitcnt lgkmcnt(0)" ::: "memory");
            { const int orow = lane >> 2, oc = (lane & 3) * 16;
              const u32x4 w0 = *(const LAS u32x4*)(Pw + orow * 264 + oc), w1 = *(const LAS u32x4*)(Pw + orow * 264 + oc + 8);
              bf16_t* op = O + (size_t)(b * SEQ + n * 128 + 16 * w + orow) * 1024 + head * 64 + oc;
              *(u32x4*)op = w0; *(u32x4*)(op + 8) = w1; }
            asm volatile("s_waitcnt lgkmcnt(0)" ::: "memory");
        }
    }
}

#define HG_CUMSUM(LOGF, row0, h, TOT) \
    const int d = tid & 127, part = tid >> 7; float lf[16], cu[16]; \
    { float run = 0.f; _Pragma("unroll") for (int i = 0; i < 16; ++i) { lf[i] = LOGF[(size_t)(row0 + 16 * part + i) * 1024 + h * 128 + d]; run += lf[i]; cu[i] = run; } \
      TOT[part * 128 + d] = run; } \
    __syncthreads(); \
    float last, pre = 0.f; { const float t0_ = TOT[d], t1_ = TOT[128 + d], t2_ = TOT[256 + d], t3_ = TOT[384 + d]; last = (t0_ + t1_) + (t2_ + t3_); \
      pre = part == 0 ? 0.f : (part == 1 ? t0_ : (part == 2 ? t0_ + t1_ : (t0_ + t1_) + t2_)); } \
    _Pragma("unroll") for (int i = 0; i < 16; ++i) cu[i] += pre;

__device__ __forceinline__ void pack16_store(LAS bf16_t* dst, const float (&v)[16]) {
    u32x4 a, b; a.x = cvt_pk_bf16(v[0], v[1]); a.y = cvt_pk_bf16(v[2], v[3]); a.z = cvt_pk_bf16(v[4], v[5]); a.w = cvt_pk_bf16(v[6], v[7]);
    b.x = cvt_pk_bf16(v[8], v[9]); b.y = cvt_pk_bf16(v[10], v[11]); b.z = cvt_pk_bf16(v[12], v[13]); b.w = cvt_pk_bf16(v[14], v[15]);
    *(LAS u32x4*)dst = a; *(LAS u32x4*)(dst + 8) = b;
}
__device__ __forceinline__ void hgrn_pass1(const Ctx& C, const float* LOGF, const bf16_t* IB, bf16_t* STATE, float* DECAY) {
    const int tid = C.tid, lane = C.lane, w = C.wave, fr = lane & 15, fq = lane >> 4;
    LAS bf16_t* KbT = (LAS bf16_t*)C.lds;
    LAS bf16_t* VT = (LAS bf16_t*)(C.lds + 18432);
    LAS float* TOT = (LAS float*)(C.lds + 36864);
    for (int unit = C.bid; unit < 2048; unit += C.G) {
        const int b = unit >> 9, h = (unit >> 6) & 7, c = unit & 63, row0 = b * SEQ + c * 64;
        __syncthreads();
        HG_CUMSUM(LOGF, row0, h, TOT)
        float kb[16], vv[16];
#pragma unroll
        for (int i = 0; i < 16; ++i) { kb[i] = (1.f - ex2(lf[i])) * ex2(last - cu[i]); vv[i] = bf2f(IB[(size_t)(row0 + 16 * part + i) * 1024 + h * 128 + d]); }
        pack16_store(KbT + d * 72 + 16 * part, kb); pack16_store(VT + d * 72 + 16 * part, vv);
        if (part == 0) DECAY[(size_t)unit * 128 + d] = ex2(last);
        __syncthreads();
        bf16x8 a0 = *(const LAS bf16x8*)(KbT + (16 * w + fr) * 72 + 8 * fq), a1 = *(const LAS bf16x8*)(KbT + (16 * w + fr) * 72 + 32 + 8 * fq);
        bf16x8 vb[8][2];
#pragma unroll
        for (int et = 0; et < 8; ++et) { vb[et][0] = *(const LAS bf16x8*)(VT + (16 * et + fr) * 72 + 8 * fq); vb[et][1] = *(const LAS bf16x8*)(VT + (16 * et + fr) * 72 + 32 + 8 * fq); }
        __builtin_amdgcn_sched_barrier(0);
#pragma unroll
        for (int et = 0; et < 8; ++et) { f32x4 acc = {0.f, 0.f, 0.f, 0.f};
            acc = MFMA16(a0, vb[et][0], acc); acc = MFMA16(a1, vb[et][1], acc);
            u32x2 o; o.x = cvt_pk_bf16(acc[0], acc[1]); o.y = cvt_pk_bf16(acc[2], acc[3]);
            *(u32x2*)(STATE + (size_t)unit * 16384 + (16 * et + fr) * 128 + 16 * w + 4 * fq) = o; }
    }
}
__device__ __forceinline__ void hgrn_pass2(const Ctx& C, bf16_t* STATE, const float* DECAY) {
    for (int idx = C.bid * NTHREADS + C.tid; idx < 32 * 4096; idx += C.G * NTHREADS) {
        const int bh = idx >> 12, el = (idx & 4095) * 4; f32x4 s = {0.f, 0.f, 0.f, 0.f};
#pragma unroll 4
        for (int c = 0; c < 64; ++c) { const size_t unit = (size_t)bh * 64 + c; bf16_t* p = STATE + unit * 16384 + el;
            const u32x2 raw = *(const u32x2*)p; const f32x4 dec = *(const f32x4*)(DECAY + unit * 128 + (el & 127));
            u32x2 o; o.x = cvt_pk_bf16(s[0], s[1]); o.y = cvt_pk_bf16(s[2], s[3]); *(u32x2*)p = o;
            const f32x4 dl = (f32x4){bflo(raw.x), bfhi(raw.x), bflo(raw.y), bfhi(raw.y)}; s = dec * s + dl; }
    }
}
__device__ __forceinline__ void hgrn_pass3(const Ctx& C, const float* LOGF, const bf16_t* QB, const bf16_t* IB, const bf16_t* OG, const bf16_t* STATE, const float* hnorm, bf16_t* OUTB) {
    const int tid = C.tid, lane = C.lane, w = C.wave, fr = lane & 15, fq = lane >> 4;
    LAS bf16_t* Qt = (LAS bf16_t*)C.lds;
    LAS bf16_t* Kt = (LAS bf16_t*)(C.lds + 17408);
    LAS bf16_t* VT = (LAS bf16_t*)(C.lds + 34816);
    LAS bf16_t* ST = (LAS bf16_t*)(C.lds + 53248);
    LAS bf16_t* Am = (LAS bf16_t*)(C.lds + 88064);
    LAS float* TOT = (LAS float*)(C.lds + 97280);
    LAS float* SSQ = (LAS float*)(C.lds + 99328);
    for (int unit = C.bid; unit < 2048; unit += C.G) {
        const int b = unit >> 9, h = (unit >> 6) & 7, c = unit & 63, row0 = b * SEQ + c * 64;
        __syncthreads();
        {
            HG_CUMSUM(LOGF, row0, h, TOT)
            float vv[16];
#pragma unroll
            for (int i = 0; i < 16; ++i) { const size_t g = (size_t)(row0 + 16 * part + i) * 1024 + h * 128 + d;
                const float qs = bf2f(QB[g]); vv[i] = bf2f(IB[g]);
                Qt[(16 * part + i) * 136 + d] = f2bf(qs * ex2(cu[i])); Kt[(16 * part + i) * 136 + d] = f2bf((1.f - ex2(lf[i])) * ex2(-cu[i])); }
            pack16_store(VT + d * 72 + 16 * part, vv);
#pragma unroll
            for (int i = 0; i < 4; ++i) { const int ch = tid + 512 * i, e = ch >> 4, c8 = (ch & 15) * 8; *(LAS u32x4*)(ST + e * 136 + c8) = *(const u32x4*)(STATE + (size_t)unit * 16384 + e * 128 + c8); }
        }
        __syncthreads();
        const int tt = w >> 1;
        {
            bf16x8 qa[4];
#pragma unroll
            for (int ks = 0; ks < 4; ++ks) qa[ks] = *(const LAS bf16x8*)(Qt + (16 * tt + fr) * 136 + 32 * ks + 8 * fq);
            bf16x8 kb2[2][4];
#pragma unroll
            for (int s2 = 0; s2 < 2; ++s2)
#pragma unroll
                for (int ks = 0; ks < 4; ++ks) kb2[s2][ks] = *(const LAS bf16x8*)(Kt + (16 * (2 * (w & 1) + s2) + fr) * 136 + 32 * ks + 8 * fq);
            __builtin_amdgcn_sched_barrier(0);
#pragma unroll
            for (int s2 = 0; s2 < 2; ++s2) { const int st = 2 * (w & 1) + s2; f32x4 acc = {0.f, 0.f, 0.f, 0.f};
#pragma unroll
                for (int ks = 0; ks < 4; ++ks) acc = MFMA16(qa[ks], kb2[s2][ks], acc);
#pragma unroll
                for (int r = 0; r < 4; ++r) { const int t = 16 * tt + 4 * fq + r, s = 16 * st + fr; Am[t * 72 + s] = f2bf(s <= t ? acc[r] : 0.f); } }
        }
        __syncthreads();
        f32x4 o[4]; float pr[4] = {0.f, 0.f, 0.f, 0.f};
        {
            bf16x8 am[2], qa[4];
#pragma unroll
            for (int ks = 0; ks < 2; ++ks) am[ks] = *(const LAS bf16x8*)(Am + (16 * tt + fr) * 72 + 32 * ks + 8 * fq);
#pragma unroll
            for (int ks = 0; ks < 4; ++ks) qa[ks] = *(const LAS bf16x8*)(Qt + (16 * tt + fr) * 136 + 32 * ks + 8 * fq);
            bf16x8 vtf[4][2], stf[4][4];
#pragma unroll
            for (int j = 0; j < 4; ++j) { const int et = 4 * (w & 1) + j;
#pragma unroll
                for (int ks = 0; ks < 2; ++ks) vtf[j][ks] = *(const LAS bf16x8*)(VT + (16 * et + fr) * 72 + 32 * ks + 8 * fq);
#pragma unroll
                for (int ks = 0; ks < 4; ++ks) stf[j][ks] = *(const LAS bf16x8*)(ST + (16 * et + fr) * 136 + 32 * ks + 8 * fq); }
            __builtin_amdgcn_sched_barrier(0);
#pragma unroll
            for (int j = 0; j < 4; ++j) { f32x4 acc = {0.f, 0.f, 0.f, 0.f};
#pragma unroll
                for (int ks = 0; ks < 2; ++ks) acc = MFMA16(am[ks], vtf[j][ks], acc);
#pragma unroll
                for (int ks = 0; ks < 4; ++ks) acc = MFMA16(qa[ks], stf[j][ks], acc);
                o[j] = acc;
#pragma unroll
                for (int r = 0; r < 4; ++r) pr[r] += acc[r] * acc[r]; }
        }
#pragma unroll
        for (int r = 0; r < 4; ++r) { pr[r] = grp16_sum(pr[r]); if (fr == 0) SSQ[(16 * tt + 4 * fq + r) * 2 + (w & 1)] = pr[r]; }
        __syncthreads();
        float hn[4]; unsigned ogr[4][4];
#pragma unroll
        for (int j = 0; j < 4; ++j) hn[j] = hnorm[h * 128 + 16 * (4 * (w & 1) + j) + fr];
#pragma unroll
        for (int r = 0; r < 4; ++r)
#pragma unroll
            for (int j = 0; j < 4; ++j) ogr[r][j] = OG[(size_t)(row0 + 16 * tt + 4 * fq + r) * 1024 + h * 128 + 16 * (4 * (w & 1) + j) + fr];
        LAS bf16_t* Ow = (LAS bf16_t*)(C.lds + 100352 + w * 2304);
#pragma unroll
        for (int r = 0; r < 4; ++r) { const int t = 16 * tt + 4 * fq + r; const float rstd = 1.0f / sqrtf((SSQ[t * 2] + SSQ[t * 2 + 1]) * (1.f / 128.f) + EPS);
#pragma unroll
            for (int j = 0; j < 4; ++j) Ow[(4 * fq + r) * 72 + 16 * j + fr] = f2bf(o[j][r] * rstd * hn[j] * bf2f(ogr[r][j])); }
        asm volatile("s_waitcnt lgkmcnt(0)" ::: "memory");
        { const int orow = lane >> 2, oc = (lane & 3) * 16;
          const u32x4 w0 = *(const LAS u32x4*)(Ow + orow * 72 + oc), w1 = *(const LAS u32x4*)(Ow + orow * 72 + oc + 8);
          bf16_t* op = OUTB + (size_t)(row0 + 16 * tt + orow) * 1024 + h * 128 + 64 * (w & 1) + oc;
          *(u32x4*)op = w0; *(u32x4*)(op + 8) = w1; }
    }
}


#define XB_TMO      128
#define XB_XCNT(j)  (256  + 64 * (j))
#define XB_XSUB(j)  (1280 + 64 * (j))
#define XB_XGEN(j)  (2304 + 64 * (j))
#define XB_TOP      3328
#define XB_TOPGEN   3392
#define XCD_BAR_WORDS 3456
#define XB_SPIN_CAP (1u << 18)
__device__ __forceinline__ unsigned xb_ld(unsigned* p)              { return __hip_atomic_load(p, __ATOMIC_RELAXED, __HIP_MEMORY_SCOPE_AGENT); }
__device__ __forceinline__ unsigned xb_add(unsigned* p, unsigned v) { return __hip_atomic_fetch_add(p, v, __ATOMIC_RELAXED, __HIP_MEMORY_SCOPE_AGENT); }
__device__ __forceinline__ unsigned xb_xcc_id() { return (unsigned)__builtin_amdgcn_s_getreg((3 << 11) | 20) & 0xFu; }
#define XB_SPIN(cond, bar) do { unsigned _sp = 0; while (cond) { __builtin_amdgcn_s_sleep(1); \
    if ((++_sp & 255u) == 0u) { if (xb_ld(&(bar)[XB_TMO])) break; if (_sp > XB_SPIN_CAP) { atomicAdd(&(bar)[XB_TMO], 1u); break; } } } } while (0)
struct XcdBarrier { unsigned* bar; unsigned x; volatile LAS unsigned* st; };
__device__ __forceinline__ XcdBarrier xcd_barrier_post(unsigned* bar, volatile LAS unsigned* st) {
    XcdBarrier b; b.bar = bar; b.x = xb_xcc_id(); b.st = st;
    if (threadIdx.x == 0) st[2] = xb_add(&bar[XB_XCNT(b.x)], 1u);
    return b;
}
__device__ __forceinline__ void xcd_barrier_complete(unsigned* bar, unsigned x, unsigned& nloc, unsigned& nx) {
    const unsigned G = gridDim.x * gridDim.y * gridDim.z;
    unsigned sum, cnt, mine, sp = 0u;
    for (;;) {
        sum = 0u; cnt = 0u; mine = 0u;
#pragma unroll
        for (unsigned j = 0; j < 16; ++j) { const unsigned c = xb_ld(&bar[XB_XCNT(j)]); sum += c; cnt += (c > 0u) ? 1u : 0u; mine = (j == x) ? c : mine; }
        if (sum == G) break;
        __builtin_amdgcn_s_sleep(1);
        if ((++sp & 255u) == 0u) { if (xb_ld(&bar[XB_TMO])) break; if (sp > XB_SPIN_CAP) { atomicAdd(&bar[XB_TMO], 1u); break; } }
    }
    nloc = mine > 0u ? mine : 1u; nx = cnt > 0u ? cnt : 1u;
}
__device__ __forceinline__ void xcd_barrier(const XcdBarrier& b) {
    asm volatile("s_waitcnt vmcnt(0)" ::: "memory");
    __syncthreads();
    if (threadIdx.x == 0) {
        unsigned* bar = b.bar;
        __builtin_amdgcn_s_waitcnt(0);
        unsigned nloc = b.st[0], nx = b.st[1];
        if (nloc == 0u) { xcd_barrier_complete(bar, b.x, nloc, nx); b.st[0] = nloc; b.st[1] = nx; }
        const unsigned old = xb_add(&bar[XB_XSUB(b.x)], 1u);
        const unsigned gen = old / nloc;
        if (old + 1u == (gen + 1u) * nloc) {
            __builtin_amdgcn_fence(__ATOMIC_RELEASE, "agent");
            asm volatile("s_waitcnt vmcnt(0)" ::: "memory");
            const unsigned og = xb_add(&bar[XB_TOP], 1u);
            const unsigned tg = og / nx;
            if (og + 1u == (tg + 1u) * nx) xb_add(&bar[XB_TOPGEN], 1u);
            else XB_SPIN(xb_ld(&bar[XB_TOPGEN]) == tg, bar);
            __builtin_amdgcn_fence(__ATOMIC_ACQUIRE, "agent");
            xb_add(&bar[XB_XGEN(b.x)], 1u);
            asm volatile("s_waitcnt vmcnt(0)" ::: "memory");
        } else {
            XB_SPIN(xb_ld(&bar[XB_XGEN(b.x)]) == gen, bar);
            __builtin_amdgcn_fence(__ATOMIC_ACQUIRE, "agent");
            asm volatile("s_waitcnt vmcnt(0)" ::: "memory");
        }
    }
    __syncthreads();
}
__global__ void __launch_bounds__(NTHREADS, 2) mega_fwd(Args args) {
    extern __shared__ __attribute__((aligned(16))) unsigned char lds_raw[];
    cg::grid_group grid = cg::this_grid();
    Ctx C; C.lds = (LAS unsigned char*)lds_raw; C.tid = threadIdx.x; C.lane = C.tid & 63; C.wave = __builtin_amdgcn_readfirstlane(C.tid >> 6); C.G = gridDim.x; C.bid = blockIdx.x;
    unsigned char* const ws = args.ws;
#define PX ((const float*)args.in[0])
#define POUT (args.out)
#define P_ROPEC ((float*)(ws + WS_ROPE))
#define P_ROPES ((float*)(ws + WS_ROPE) + T * 8)
#define WGU ((bf16_t*)(ws + WS_WA_GU))
#define WD ((bf16_t*)(ws + WS_WA_D))
#define WIN ((bf16_t*)(ws + WS_WIN))
#define WUA ((bf16_t*)(ws + WS_WUA))
#define WUB ((bf16_t*)(ws + WS_WUB))
#define WOUT ((bf16_t*)(ws + WS_WOUT))
#define WPG ((bf16_t*)(ws + WS_WPG))
#define WPP ((bf16_t*)(ws + WS_WPP))
#define H ((bf16_t*)(ws + WS_H))
#define ACT ((bf16_t*)(ws + WS_ACT))
#define Qb ((bf16_t*)(ws + WS_Q))
#define Kb ((bf16_t*)(ws + WS_K))
#define Vb ((bf16_t*)(ws + WS_V))
#define QB ((bf16_t*)(ws + WS_QB))
#define IB ((bf16_t*)(ws + WS_IB))
#define OG ((bf16_t*)(ws + WS_OG))
#define GA ((bf16_t*)(ws + WS_GA))
#define GB ((bf16_t*)(ws + WS_GB))
#define LOGF ((float*)(ws + WS_LOGF))
#define OUTA ((bf16_t*)(ws + WS_OUTA))
#define OUTB ((bf16_t*)(ws + WS_OUTB))
#define STATE ((bf16_t*)(ws + WS_STATE))
#define DECAY ((float*)(ws + WS_DECAY))
#define PBF ((bf16_t*)(ws + WS_PBF))
#define PP ((bf16_t*)(ws + WS_PP))
#define SSQ0 ((float*)(ws + WS_SS))
    volatile LAS unsigned* xst = (volatile LAS unsigned*)(C.lds + LDS_BYTES - 64);
    if (C.tid < 4) xst[C.tid] = 0u;
    __syncthreads();
    if (args.ph_hi - args.ph_lo > 1) {
        if (C.bid == 0) { unsigned* bw = (unsigned*)(ws + WS_BAR); for (int i = C.tid; i < 4096; i += NTHREADS) bw[i] = 0u; }
        asm volatile("s_waitcnt vmcnt(0)" ::: "memory");
        grid.sync(); }
    const XcdBarrier xbar = xcd_barrier_post((unsigned*)(ws + WS_BAR), xst);
    const int lo = args.ph_lo, hi = args.ph_hi;
#ifndef PHASE_MASK
#define PHASE_MASK 0xffff
#endif
#define IN(k) ((((PHASE_MASK) >> (k)) & 1) && lo <= (k) && (k) < hi)
#define SEAM(k) do { if (IN(k) && IN((k) + 1)) { asm volatile("s_waitcnt vmcnt(0) lgkmcnt(0)" ::: "memory"); xcd_barrier(xbar); } } while (0)
    pg8::StaticOrder S;

    if (IN(0)) {
        for (int i = C.bid * NTHREADS + C.tid; i < 4 * T; i += C.G * NTHREADS) SSQ0[i] = 0.f;
        conv_matrix(C, (const float*)args.in[4], DM, FF, WGU, 128, 256, 0);
        conv_matrix(C, (const float*)args.in[5], DM, FF, WGU, 128, 256, 128);
        conv_matrix(C, (const float*)args.in[6], FF, DM, WD, DM, 0, 0, true);
        conv_matrix(C, (const float*)args.in[8], DM, IND, WIN, IND, 0, 0);
        conv_matrix(C, (const float*)args.in[12], 1024, DM, WUA, DM, 0, 0);
        conv_matrix(C, (const float*)args.in[13], 1024, DM, WUB, DM, 0, 0);
        conv_matrix(C, (const float*)args.in[14], DM, DM, WOUT, DM, 0, 0);
        conv_matrix(C, (const float*)args.in[20], DM, DM, WPG, DM, 0, 0);
        conv_matrix(C, (const float*)args.in[21], PLE, DM, WPP, DM, 0, 0);
        rope_tables(C, (const int*)args.in[2], P_ROPEC, P_ROPES);
        norm_rows_bf16(C, PX, (const float*)args.in[3], H);
    }
    SEAM(0);
    int gbid = C.bid;
    {
        if (C.tid == 0) { unsigned* bar = (unsigned*)(ws + WS_BAR); bool ok = (C.G % 8) == 0;
            for (unsigned j = 0; j < 16; ++j) { const unsigned c = xb_ld(&bar[XB_XCNT(j)]); ok = ok && (c == (j < 8 ? (unsigned)C.G / 8u : 0u)); }
            xst[3] = ok ? (xst[2] * 8u + xbar.x) : (unsigned)C.bid; }
        __syncthreads();
        gbid = (int)xst[3];
    }
    if (IN(1)) { pg8::Gemm g{H, WGU, T, 2 * FF, DM}; S.init(T, 2 * FF, C.G, gbid); EpiSwiGLU E{ACT, nullptr}; pg8::gemm_phase(C.lds, g, S, E); }
    SEAM(1);
    if (IN(2)) { pg8::Gemm g{ACT, WD, T, DM, FF}; S.init(T, DM, C.G, gbid); EpiResidNorm E{PX, POUT, 0.5f, (const float*)args.in[7], H, SSQ0}; pg8::gemm_phase<EpiResidNorm, true, true>(C.lds, g, S, E); }
    SEAM(2);
    if (IN(3)) { pg8::Gemm g{H, WIN, T, IND, DM}; S.init(T, IND, C.G, gbid);
        EpiProj E{Qb, Kb, Vb, QB, IB, OG, GA, GB, LOGF, P_ROPEC, P_ROPES, (const float*)args.in[10], SSQ0}; pg8::gemm_phase(C.lds, g, S, E); }
    SEAM(3);
    if (IN(4)) { attn_phase(C, Qb, Kb, Vb, (const float*)args.in[9], OUTA); hgrn_pass1(C, LOGF, IB, STATE, DECAY); }
    SEAM(4);
    if (IN(5)) { hgrn_pass2(C, STATE, DECAY); __syncthreads();
        pg8::Gemm g{OUTA, WUA, T, DM, 1024}; S.init(T, DM, C.G, gbid); EpiBf<1> E{GA, nullptr}; pg8::gemm_phase(C.lds, g, S, E); }
    SEAM(5);
    if (IN(6)) hgrn_pass3(C, LOGF, QB, IB, OG, STATE, (const float*)args.in[11], OUTB);
    SEAM(6);
    if (IN(7)) {
        conv_matrix(C, (const float*)args.in[16], DM, FF, WGU, 128, 256, 0);
        conv_matrix(C, (const float*)args.in[17], DM, FF, WGU, 128, 256, 128);
        conv_matrix(C, (const float*)args.in[18], FF, DM, WD, DM, 0, 0, true);
        conv_p(C, (const float*)args.in[1], PBF); __syncthreads();
        pg8::Gemm g{OUTB, WUB, T, DM, 1024}; S.init(T, DM, C.G, gbid); EpiBf<2> E{GB, GA}; pg8::gemm_phase(C.lds, g, S, E); }
    SEAM(7);
    if (IN(8)) { pg8::Gemm g{GB, WOUT, T, DM, DM}; S.init(T, DM, C.G, gbid); EpiResidNorm E{POUT, POUT, 1.0f, (const float*)args.in[15], H, SSQ0 + T}; pg8::gemm_phase(C.lds, g, S, E); }
    SEAM(8);
    if (IN(9)) { { pg8::Gemm g{PBF, WPP, T, DM, PLE}; S.init(T, DM, C.G, gbid); EpiBf<0> E{PP, nullptr}; pg8::gemm_phase(C.lds, g, S, E); }
        pg8::Gemm g{H, WGU, T, 2 * FF, DM}; S.init(T, 2 * FF, C.G, gbid); EpiSwiGLU E{ACT, SSQ0 + T}; pg8::gemm_phase(C.lds, g, S, E); }
    SEAM(9);
    if (IN(10)) { pg8::Gemm g{ACT, WD, T, DM, FF}; S.init(T, DM, C.G, gbid); EpiResidNorm E{POUT, POUT, 0.5f, (const float*)args.in[19], H, SSQ0 + 2 * T}; pg8::gemm_phase<EpiResidNorm, true, true>(C.lds, g, S, E); }
    SEAM(10);
    if (IN(11)) { pg8::Gemm g{H, WPG, T, DM, DM}; S.init(T, DM, C.G, gbid, 4);
        EpiPleFinal E{POUT, POUT, PP, SSQ0 + 2 * T, SSQ0 + 3 * T, (unsigned*)(ws + WS_BAR) + 3584, (const float*)args.in[22]}; pg8::gemm_phase(C.lds, g, S, E); }
#undef IN
#undef SEAM
}

#ifndef PH_RUN
#define PH_RUN 0xffff
#endif
#ifndef DUP_MASK
#define DUP_MASK 0x0
#endif
#ifndef MK_PER_PHASE
#define MK_PER_PHASE 0
#endif
extern "C" void kernel_launch(void* const* d_in, const int* in_sizes, int n_in, void* d_out, int out_size, void* d_ws, size_t ws_size, hipStream_t stream) {
    static int grid = 0;
    if (grid == 0) {
        if (n_in != 23 || out_size != T * DM || ws_size < WS_END) { fprintf(stderr, "kernel_launch: unexpected problem (n_in %d, out %d, ws %zu)\n", n_in, out_size, ws_size); grid = -1; return; }
        int dev = 0, cus = 0, per_cu = 0;
        (void)hipGetDevice(&dev); (void)hipDeviceGetAttribute(&cus, hipDeviceAttributeMultiprocessorCount, dev);
        if (hipFuncSetAttribute((const void*)mega_fwd, hipFuncAttributeMaxDynamicSharedMemorySize, LDS_BYTES) != hipSuccess) { fprintf(stderr, "kernel_launch: hipFuncSetAttribute failed\n"); grid = -1; return; }
        if (hipOccupancyMaxActiveBlocksPerMultiprocessor(&per_cu, (const void*)mega_fwd, NTHREADS, LDS_BYTES) != hipSuccess || per_cu < 1) per_cu = 1;
        (void)hipGetLastError();
        grid = cus > 0 ? cus : 256;
    }
    if (grid < 0) return;
    Args a{};
    for (int i = 0; i < 23; ++i) a.in[i] = d_in[i];
    a.out = (float*)d_out; a.ws = (unsigned char*)d_ws;
#if MK_PER_PHASE
    for (int ph = 0; ph < 13; ++ph) { if (!((PH_RUN >> ph) & 1)) continue; a.ph_lo = ph; a.ph_hi = ph + 1; for (int rep = 0; rep < (((DUP_MASK >> ph) & 1) ? 2 : 1); ++rep) hipLaunchKernelGGL(mega_fwd, dim3(grid), dim3(NTHREADS), LDS_BYTES, stream, a); }
#else
    a.ph_lo = 0; a.ph_hi = 12;
    void* kargs[] = {&a};
    hipError_t e = hipLaunchCooperativeKernel((const void*)mega_fwd, dim3(grid), dim3(NTHREADS), kargs, LDS_BYTES, stream);
    if (e != hipSuccess) fprintf(stderr, "cooperative launch failed: %s (grid %d)\n", hipGetErrorString(e), grid);
#endif
}
```
